# Optimizing an MI355X kernel written in HIP

```python
import math
import jax, jax.numpy as jnp
from jax import lax
import numpy as np

D_MODEL = 2048
BATCH = 4
SEQ = 4096
DEPTH = 1

CHUNK = 64
N_META = 16
Q_BLOCK = 128
RMS_EPS = 1e-5

SB_HEAD_DIM = 128
SB_HEADS = (D_MODEL // 2) // SB_HEAD_DIM
SB_WIDTH = SB_HEADS * SB_HEAD_DIM
DA_HEAD_DIM = 64
DA_V_DIM = 2 * DA_HEAD_DIM
DA_HEADS = (D_MODEL // 2) // DA_V_DIM
DA_QK_WIDTH = DA_HEADS * 2 * DA_HEAD_DIM
DA_WIDTH = DA_HEADS * DA_V_DIM
MIX_WIDTH = SB_WIDTH + DA_WIDTH
IN_COLS = 3 * SB_WIDTH + 2 * DA_QK_WIDTH + DA_WIDTH
SPLIT_POINTS = (SB_WIDTH, 2 * SB_WIDTH, 3 * SB_WIDTH,
                3 * SB_WIDTH + DA_QK_WIDTH, 3 * SB_WIDTH + 2 * DA_QK_WIDTH)
ROPE_THETA = 500000.0
ROPE_DIM = DA_HEAD_DIM // 4

N_EXPERTS = 32
TOP_K = 4
D_EXPERT = D_MODEL
SWIGLU_LIMIT = 7.0
SWIGLU_ALPHA = 1.702
MOE_BLOCK = 256

kernel_name = "hymba_stickbreak_diffattn_moe"


def _rmsnorm(x, g):
    xf = x.astype(jnp.float32)
    y = xf * lax.rsqrt(jnp.mean(xf * xf, axis=-1, keepdims=True) + RMS_EPS)
    return (y * g.astype(jnp.float32)).astype(x.dtype)


def _partial_rope(x, pos):
    half = ROPE_DIM // 2
    inv_freq = ROPE_THETA ** (-(jnp.arange(half, dtype=jnp.float32) * 2.0 / ROPE_DIM))
    ang = pos.astype(jnp.float32)[:, None] * inv_freq[None, :]
    cos = jnp.cos(ang)[None, :, None, None, :]
    sin = jnp.sin(ang)[None, :, None, None, :]
    xr = x[..., :ROPE_DIM].astype(jnp.float32)
    x1, x2 = xr[..., :half], xr[..., half:]
    rot = jnp.concatenate([x1 * cos - x2 * sin, x2 * cos + x1 * sin], axis=-1)
    return jnp.concatenate([rot.astype(x.dtype), x[..., ROPE_DIM:]], axis=-1)


def _chunk_ids(pos, n_valid):
    real = 1 + (pos - N_META) // CHUNK
    c = jnp.where(pos < N_META, 0, real)
    return jnp.where(pos < n_valid, c, jnp.iinfo(jnp.int32).max).astype(jnp.int32)


def _stick_breaking_attention(q, k, v):
    b, h, lp, d = q.shape
    nb = lp // Q_BLOCK
    q_blocks = q.reshape(b, h, nb, Q_BLOCK, d).transpose(2, 0, 1, 3, 4)
    k_pos = jnp.arange(lp, dtype=jnp.int32)
    scale = d ** -0.5

    def one_block(args):
        q_blk, blk = args
        z = jnp.einsum('bhqd,bhkd->bhqk', q_blk, k).astype(jnp.float32) * scale
        q_pos = blk * Q_BLOCK + jnp.arange(Q_BLOCK, dtype=jnp.int32)
        strict = k_pos[None, :] < q_pos[:, None]
        log_keep = jnp.where(strict, jax.nn.log_sigmoid(-z), 0.0)
        log_survive = lax.cumsum(log_keep, axis=3, reverse=True) - log_keep
        w = jnp.where(strict, jnp.exp(jax.nn.log_sigmoid(z) + log_survive), 0.0)
        return jnp.einsum('bhqk,bhkd->bhqd', w.astype(v.dtype), v)

    out = lax.map(one_block, (q_blocks, jnp.arange(nb, dtype=jnp.int32)))
    return out.transpose(1, 0, 3, 2, 4).reshape(b, lp, h, v.shape[-1])


def _differential_attention(q, k, v, lam, chunk):
    b, h, _, lp, d = q.shape
    nb = lp // Q_BLOCK
    q_blocks = q.reshape(b, h, 2, nb, Q_BLOCK, d).transpose(3, 0, 1, 2, 4, 5)
    q_chunks = chunk.reshape(nb, Q_BLOCK)
    scale = d ** -0.5

    def one_block(args):
        q_blk, q_chunk = args
        s = jnp.einsum('bhcqd,bhckd->bhcqk', q_blk, k).astype(jnp.float32) * scale
        visible = chunk[None, :] <= q_chunk[:, None]
        p = jax.nn.softmax(jnp.where(visible, s, -jnp.inf), axis=-1)
        a = p[:, :, 0] - lam * p[:, :, 1]
        return jnp.einsum('bhqk,bhkd->bhqd', a.astype(v.dtype), v)

    out = lax.map(one_block, (q_blocks, q_chunks))
    return out.transpose(1, 0, 3, 2, 4).reshape(b, lp, h, v.shape[-1])


def _moe(x, w_router, b_router, w_gate_up, b_gate_up, w_down, b_down):
    n_tok, d = x.shape
    n_assign = n_tok * TOP_K
    logits = (x @ w_router + b_router).astype(jnp.float32)
    top_logit, top_e = lax.top_k(logits, TOP_K)
    gates = jax.nn.softmax(top_logit, axis=-1)
    flat_e = top_e.reshape(-1).astype(jnp.int32)
    flat_tok = jnp.repeat(jnp.arange(n_tok, dtype=jnp.int32), TOP_K)
    flat_g = gates.reshape(-1)
    order = jnp.argsort(flat_e, stable=True)
    e_s, tok_s, g_s = flat_e[order], flat_tok[order], flat_g[order]
    counts = jnp.bincount(flat_e, length=N_EXPERTS).astype(jnp.int32)
    padded = (counts + MOE_BLOCK - 1) // MOE_BLOCK * MOE_BLOCK
    pad_end = jnp.cumsum(padded).astype(jnp.int32)
    pad_start = pad_end - padded
    grp_start = jnp.cumsum(counts).astype(jnp.int32) - counts
    dest = pad_start[e_s] + (jnp.arange(n_assign, dtype=jnp.int32) - grp_start[e_s])
    n_blocks = -(-n_assign // MOE_BLOCK) + N_EXPERTS
    rows = jnp.zeros((n_blocks * MOE_BLOCK, d), x.dtype).at[dest].set(x[tok_s])
    blk_start = jnp.arange(n_blocks, dtype=jnp.int32) * MOE_BLOCK
    blk_e = jnp.minimum(jnp.searchsorted(pad_end, blk_start, side='right'), N_EXPERTS - 1)
    blk_used = blk_start < pad_end[-1]

    def expert_ffn(xb, e):
        hgu = xb @ w_gate_up[e] + b_gate_up[e]
        gate = jnp.minimum(hgu[:, :D_EXPERT], SWIGLU_LIMIT)
        up = jnp.clip(hgu[:, D_EXPERT:], -SWIGLU_LIMIT, SWIGLU_LIMIT)
        act = (up + 1.0) * gate * jax.nn.sigmoid(SWIGLU_ALPHA * gate)
        return (act @ w_down[e] + b_down[e]).astype(xb.dtype)

    def one_block(args):
        xb, e, used = args
        return lax.cond(used, expert_ffn, lambda xb_, e_: jnp.zeros_like(xb_), xb, e)

    out_rows = lax.map(one_block, (rows.reshape(n_blocks, MOE_BLOCK, d), blk_e, blk_used))
    out_rows = out_rows.reshape(n_blocks * MOE_BLOCK, d)
    y = out_rows[dest] * g_s[:, None].astype(x.dtype)
    return jax.ops.segment_sum(y, tok_s, num_segments=n_tok)


def setup_inputs(seed: int = 0) -> dict:
    key = jax.random.key(seed)
    ks = jax.random.split(key, 19)
    f32 = jnp.float32
    nrm = lambda k, shape: jax.random.normal(k, shape, f32)
    return {
        'x': nrm(ks[0], (BATCH, SEQ, D_MODEL)),
        'meta_tokens': nrm(ks[1], (N_META, D_MODEL)),
        'g_mix': 1.0 + 0.02 * nrm(ks[2], (DEPTH, D_MODEL)),
        'w_in': nrm(ks[3], (DEPTH, D_MODEL, IN_COLS)) * D_MODEL ** -0.5,
        'lam_q1': 0.1 * nrm(ks[4], (DEPTH, DA_HEAD_DIM)),
        'lam_k1': 0.1 * nrm(ks[5], (DEPTH, DA_HEAD_DIM)),
        'lam_q2': 0.1 * nrm(ks[6], (DEPTH, DA_HEAD_DIM)),
        'lam_k2': 0.1 * nrm(ks[7], (DEPTH, DA_HEAD_DIM)),
        'g_sb_out': 1.0 + 0.02 * nrm(ks[8], (DEPTH, SB_HEADS, SB_HEAD_DIM)),
        'g_da_out': 1.0 + 0.02 * nrm(ks[9], (DEPTH, DA_HEADS, DA_V_DIM)),
        'w_out': nrm(ks[10], (DEPTH, MIX_WIDTH, D_MODEL)) * MIX_WIDTH ** -0.5,
        'g_ffn': 1.0 + 0.02 * nrm(ks[11], (DEPTH, D_MODEL)),
        'w_router': nrm(ks[12], (DEPTH, D_MODEL, N_EXPERTS)) * D_MODEL ** -0.5,
        'b_router': 0.01 * nrm(ks[13], (DEPTH, N_EXPERTS)),
        'w_gate_up': nrm(ks[14], (DEPTH, N_EXPERTS, D_MODEL, 2 * D_EXPERT)) * D_MODEL ** -0.5,
        'b_gate_up': 0.01 * nrm(ks[15], (DEPTH, N_EXPERTS, 2 * D_EXPERT)),
        'w_down': nrm(ks[16], (DEPTH, N_EXPERTS, D_EXPERT, D_MODEL)) * D_EXPERT ** -0.5,
        'b_down': 0.01 * nrm(ks[17], (DEPTH, N_EXPERTS, D_MODEL)),
        'g_final': 1.0 + 0.02 * nrm(ks[18], (D_MODEL,)),
    }


def reference(x, meta_tokens, g_mix, w_in, lam_q1, lam_k1, lam_q2, lam_k2, g_sb_out, g_da_out,
              w_out, g_ffn, w_router, b_router, w_gate_up, b_gate_up, w_down, b_down, g_final):
    b, s, d = x.shape
    n_len = N_META + s
    lp = -(-n_len // Q_BLOCK) * Q_BLOCK
    pos = jnp.arange(lp, dtype=jnp.int32)
    chunk = _chunk_ids(pos, n_len)
    meta = jnp.broadcast_to(meta_tokens.astype(x.dtype)[None], (b, N_META, d))
    h = jnp.concatenate([meta, x], axis=1)

    for layer in range(DEPTH):
        lam_init = 0.8 - 0.6 * math.exp(-0.3 * layer)
        u = _rmsnorm(h, g_mix[layer])
        proj = jnp.pad(u @ w_in[layer], ((0, 0), (0, lp - n_len), (0, 0)))
        sb_q, sb_k, sb_v, da_q, da_k, da_v = jnp.split(proj, SPLIT_POINTS, axis=-1)

        def sb_heads(t):
            return t.reshape(b, lp, SB_HEADS, SB_HEAD_DIM).transpose(0, 2, 1, 3)

        def da_pair(t):
            t = _partial_rope(t.reshape(b, lp, DA_HEADS, 2, DA_HEAD_DIM), pos)
            return t.transpose(0, 2, 3, 1, 4)

        o_sb = _stick_breaking_attention(sb_heads(sb_q), sb_heads(sb_k), sb_heads(sb_v))[:, :n_len]
        lam = (jnp.exp(jnp.sum(lam_q1[layer].astype(jnp.float32) * lam_k1[layer].astype(jnp.float32)))
               - jnp.exp(jnp.sum(lam_q2[layer].astype(jnp.float32) * lam_k2[layer].astype(jnp.float32)))
               + lam_init)
        da_vh = da_v.reshape(b, lp, DA_HEADS, DA_V_DIM).transpose(0, 2, 1, 3)
        o_da = _differential_attention(da_pair(da_q), da_pair(da_k), da_vh, lam, chunk)[:, :n_len]

        o_sb = _rmsnorm(o_sb, g_sb_out[layer])
        o_da = _rmsnorm(o_da, g_da_out[layer]) * (1.0 - lam_init)
        mixed = jnp.concatenate([o_sb.reshape(b, n_len, SB_WIDTH),
                                 o_da.reshape(b, n_len, DA_WIDTH)], axis=-1)
        h = h + mixed @ w_out[layer]
        if layer == DEPTH - 1:
            h = h[:, N_META:]
        u = _rmsnorm(h, g_ffn[layer])
        n_tok = h.shape[0] * h.shape[1]
        h = h + _moe(u.reshape(n_tok, d), w_router[layer], b_router[layer], w_gate_up[layer],
                     b_gate_up[layer], w_down[layer], b_down[layer]).reshape(h.shape)

    return _rmsnorm(h, g_final)
```

```cpp
#include <hip/hip_runtime.h>
#include <cstdio>
#include <cstdint>

#ifndef N_LAUNCH_MODE
#define N_LAUNCH_MODE 0
#endif

constexpr int BATCH = 4, SEQ = 4096, DM = 2048, NTOK = BATCH * SEQ;
constexpr int NMETA = 16, KVPAD = 48, LPB = 4160;
constexpr int HW = 1024;
constexpr int INCOLS = 6144;
constexpr int NEXP = 32, TOPK = 4;
constexpr int MAXTILES = 288, NPADROWS = MAXTILES * 256;
constexpr float RMS_EPS = 1e-5f;
constexpr float LAM_INIT = 0.2f;

constexpr size_t MiB = 1u << 20;
constexpr size_t WS_CTL = 0, CTL_ZERO_BYTES = 1 * MiB;
constexpr size_t WS_ROPE = 1 * MiB;
constexpr size_t WS_WIN = 2 * MiB;
constexpr size_t WS_WOUT = 26 * MiB;
constexpr size_t WS_U = 34 * MiB;
constexpr size_t WS_SBQ = 98 * MiB, WS_DAQ = 130 * MiB;
constexpr size_t WS_SBK = 162 * MiB, WS_SBV = 195 * MiB, WS_DAK = 228 * MiB, WS_DAV = 261 * MiB;
constexpr size_t WS_MIX = 294 * MiB;
constexpr size_t WS_U2 = 358 * MiB;
constexpr size_t WS_ROUTE = 422 * MiB;
constexpr size_t WS_XS = 424 * MiB;
constexpr size_t WS_ACT = 712 * MiB;
constexpr size_t WS_YS = 1000 * MiB;
constexpr size_t WS_WGU = 1288 * MiB;
constexpr size_t WS_WDN = 1800 * MiB;
constexpr size_t WS_END = 2056 * MiB;
constexpr int CW_TMO = 0, CW_LAM = 16, CW_NTILES = 32, CW_BAR = 4096, CW_CNT = 8192  , CW_TILE_E = 12288  ;

constexpr int LDS_BYTES = 147456;
constexpr int MISC_OFF = 131072;

#define GAS __attribute__((address_space(1)))
#define LAS __attribute__((address_space(3)))
typedef unsigned short bf16;
typedef unsigned v4u __attribute__((ext_vector_type(4)));
typedef unsigned v2u __attribute__((ext_vector_type(2)));
typedef float f32x4 __attribute__((ext_vector_type(4)));
typedef float f32x16 __attribute__((ext_vector_type(16)));
typedef short bf16x8 __attribute__((ext_vector_type(8)));
#define LDS_WAIT() asm volatile("s_waitcnt lgkmcnt(0)" ::: "memory")
#define VM_WAIT() asm volatile("s_waitcnt vmcnt(0)" ::: "memory")

__device__ __forceinline__ unsigned f2bf(float f) { unsigned u = __builtin_bit_cast(unsigned, f); return (u + 0x7fffu + ((u >> 16) & 1u)) >> 16; }
__device__ __forceinline__ unsigned pk2(float lo, float hi) { return f2bf(lo) | (f2bf(hi) << 16); }
__device__ __forceinline__ float bf2f(unsigned short b) { return __builtin_bit_cast(float, (unsigned)b << 16); }
__device__ __forceinline__ float bflo(unsigned w) { return __builtin_bit_cast(float, w << 16); }
__device__ __forceinline__ float bfhi(unsigned w) { return __builtin_bit_cast(float, w & 0xffff0000u); }
__device__ __forceinline__ float wave_sum(float v) {
#pragma unroll
    for (int o = 1; o < 64; o <<= 1) v += __shfl_xor(v, o);
    return v;
}

#define XB_TMO      128
#define XB_XCNT(j)  (256  + 64 * (j))
#define XB_XSUB(j)  (1280 + 64 * (j))
#define XB_XGEN(j)  (2304 + 64 * (j))
#define XB_TOP      3328
#define XB_TOPGEN   3392
#define XCD_BAR_WORDS 3456
#define XB_SPIN_CAP (1u << 22)
__device__ __forceinline__ unsigned xb_ld(unsigned* p)              { return __hip_atomic_load(p, __ATOMIC_RELAXED, __HIP_MEMORY_SCOPE_AGENT); }
__device__ __forceinline__ unsigned xb_add(unsigned* p, unsigned v) { return __hip_atomic_fetch_add(p, v, __ATOMIC_RELAXED, __HIP_MEMORY_SCOPE_AGENT); }
__device__ __forceinline__ unsigned xb_xcc_id() { return (unsigned)__builtin_amdgcn_s_getreg((3 << 11) | 20) & 0xFu; }
#define XB_SPIN(cond, bar) do { unsigned _sp = 0; while (cond) { __builtin_amdgcn_s_sleep(1); \
    if ((++_sp & 255u) == 0u) { if (xb_ld(&(bar)[XB_TMO])) break; if (_sp > XB_SPIN_CAP) { atomicAdd(&(bar)[XB_TMO], 1u); break; } } } } while (0)
struct XcdBarrier { unsigned* bar; unsigned x; volatile LAS unsigned* st; };
__device__ __forceinline__ XcdBarrier xcd_barrier_post(unsigned* bar, volatile LAS unsigned* st) {
    XcdBarrier b; b.bar = bar; b.x = xb_xcc_id(); b.st = st;
    if (threadIdx.x == 0) (void)xb_add(&bar[XB_XCNT(b.x)], 1u);
    return b;
}
__device__ __forceinline__ void xcd_barrier_complete(unsigned* bar, unsigned x, unsigned& nloc, unsigned& nx) {
    const unsigned G = gridDim.x * gridDim.y * gridDim.z;
    unsigned sum, cnt, mine, sp = 0u;
    for (;;) {
        sum = 0u; cnt = 0u; mine = 0u;
#pragma unroll
        for (unsigned j = 0; j < 16; ++j) { const unsigned c = xb_ld(&bar[XB_XCNT(j)]); sum += c; cnt += (c > 0u) ? 1u : 0u; mine = (j == x) ? c : mine; }
        if (sum == G) break;
        __builtin_amdgcn_s_sleep(1);
        if ((++sp & 255u) == 0u) { if (xb_ld(&bar[XB_TMO])) break; if (sp > XB_SPIN_CAP) { atomicAdd(&bar[XB_TMO], 1u); break; } }
    }
    nloc = mine > 0u ? mine : 1u; nx = cnt > 0u ? cnt : 1u;
}
__device__ __forceinline__ void xcd_barrier(const XcdBarrier& b) {
    asm volatile("s_waitcnt vmcnt(0)" ::: "memory");
    __syncthreads();
    if (threadIdx.x == 0) {
        unsigned* bar = b.bar;
        __builtin_amdgcn_s_waitcnt(0);
        unsigned nloc = b.st[0], nx = b.st[1];
        if (nloc == 0u) { xcd_barrier_complete(bar, b.x, nloc, nx); b.st[0] = nloc; b.st[1] = nx; }
        const unsigned old = xb_add(&bar[XB_XSUB(b.x)], 1u);
        const unsigned gen = old / nloc;
        if (old + 1u == (gen + 1u) * nloc) {
            __builtin_amdgcn_fence(__ATOMIC_RELEASE, "agent");
            asm volatile("s_waitcnt vmcnt(0)" ::: "memory");
            const unsigned og = xb_add(&bar[XB_TOP], 1u);
            const unsigned tg = og / nx;
            if (og + 1u == (tg + 1u) * nx) xb_add(&bar[XB_TOPGEN], 1u);
            else XB_SPIN(xb_ld(&bar[XB_TOPGEN]) == tg, bar);
            __builtin_amdgcn_fence(__ATOMIC_ACQUIRE, "agent");
            xb_add(&bar[XB_XGEN(b.x)], 1u);
            asm volatile("s_waitcnt vmcnt(0)" ::: "memory");
        } else {
            XB_SPIN(xb_ld(&bar[XB_XGEN(b.x)]) == gen, bar);
            __builtin_amdgcn_fence(__ATOMIC_ACQUIRE, "agent");
            asm volatile("s_waitcnt vmcnt(0)" ::: "memory");
        }
    }
    __syncthreads();
}

namespace pg8 {
constexpr int BM = 256, BK = 64, HALF = 128, HTB = HALF * BK * 2, STAGE_BYTES = 8 * HTB, NXCD = 8, WGM = 8;
constexpr int KDIM = 2048;
__host__ __device__ __forceinline__ int lds_byte(int r, int c) { const int st = (r >> 4) * 2 + (c >> 5), rr = r & 15, cc = c & 31, ob = rr * 64 + cc * 2; return st * 1024 + (ob ^ (((ob >> 9) & 1) << 5)); }
__host__ __device__ __forceinline__ void stage_rc(int b, int& R, int& C) { const int st = b / 1024, sb = b % 1024, swz = sb ^ (((sb >> 9) & 1) << 5); R = (st >> 1) * 16 + swz / 64; C = (st & 1) * 32 + (swz % 64) / 2; }
__host__ __device__ __forceinline__ int perm32(int rho) { const int n = rho >> 4, i = rho & 15; return 8 * (i >> 2) + 4 * n + (i & 3); }

struct Unit { int pm, pn, e; const char* a; const char* b; };

struct DenseOrder {
    int nM, nN, nwg, G, c; const char* A; const char* Bt;
    __device__ void init(const bf16* A_, const bf16* Bt_, int M, int N, int G_, int c_) { nM = M / BM; nN = N / BM; nwg = nM * nN; G = G_; c = c_; A = (const char*)A_; Bt = (const char*)Bt_; }
    __device__ __forceinline__ bool next(int i, Unit& u) const {
        const long L = (long)i * G + c; if (L >= nwg) return false;
        int wgid = (int)L; { const int q = nwg / NXCD, r = nwg % NXCD, xcd = wgid % NXCD, off = wgid / NXCD; wgid = (xcd < r ? xcd * (q + 1) : r * (q + 1) + (xcd - r) * q) + off; }
        const int nig = WGM * nN, gid = wgid / nig, fm = gid * WGM, gsz = (nM - fm) < WGM ? (nM - fm) : WGM;
        u.pm = fm + ((wgid % nig) % gsz); u.pn = (wgid % nig) / gsz; u.e = 0;
        u.a = A + (size_t)u.pm * (size_t)(BM * KDIM * 2); u.b = Bt + (size_t)u.pn * (size_t)(BM * KDIM * 2); return true;
    }
};
struct MoeOrder {
    int nM, nN, nwg, G, c; const char* A; const char* Bt; const unsigned* tile_e; size_t estride;
    __device__ void init(const bf16* A_, const bf16* Bt_, int ntiles, int NE, const unsigned* tile_e_, int G_, int c_) {
        nM = ntiles; nN = NE / BM; nwg = nM * nN; G = G_; c = c_; A = (const char*)A_; Bt = (const char*)Bt_; tile_e = tile_e_; estride = (size_t)NE * KDIM * 2; }
    __device__ __forceinline__ bool next(int i, Unit& u) const {
        const long L = (long)i * G + c; if (L >= nwg) return false;
        int wgid = (int)L; { const int q = nwg / NXCD, r = nwg % NXCD, xcd = wgid % NXCD, off = wgid / NXCD; wgid = (xcd < r ? xcd * (q + 1) : r * (q + 1) + (xcd - r) * q) + off; }
        const int nig = WGM * nN, gid = wgid / nig, fm = gid * WGM, gsz = (nM - fm) < WGM ? (nM - fm) : WGM;
        u.pm = fm + ((wgid % nig) % gsz); u.pn = (wgid % nig) / gsz;
        u.e = __builtin_amdgcn_readfirstlane((int)tile_e[u.pm]);
        u.a = A + (size_t)u.pm * (size_t)(BM * KDIM * 2); u.b = Bt + (size_t)u.e * estride + (size_t)u.pn * (size_t)(BM * KDIM * 2); return true;
    }
};

__device__ __forceinline__ unsigned cvt_pk_bf16(float lo, float hi) { unsigned r; asm volatile("v_cvt_pk_bf16_f32 %0, %1, %2" : "=v"(r) : "v"(lo), "v"(hi)); return r; }

template <class Epi, class Sched>
__device__ __forceinline__ void gemm_phase(LAS unsigned char* lds, const Sched& S, const Epi& E) {
    const int tid = threadIdx.x, wid = __builtin_amdgcn_readfirstlane(tid >> 6), lane = tid & 63, wr = wid >> 2, wc = wid & 3, fr = lane & 15, fq = lane >> 4;
    constexpr int K = KDIM, nt = K / BK;
    unsigned voffA[2], voffB[2];
#pragma unroll
    for (int i = 0; i < 2; ++i) { int R, C; stage_rc(tid * 16 + i * 8192, R, C); const int Rb = Epi::PERM ? ((R & ~31) + perm32(R & 31)) : R;
        voffA[i] = (unsigned)(R * K + C) * 2u; voffB[i] = (unsigned)(Rb * K + C) * 2u; }
    const size_t kstep = (size_t)(BK * 2);
    const size_t hstep = (size_t)HALF * K * 2;
    const unsigned ldsw = (unsigned)wid * 1024u;
    const int aoff = lds_byte(wr * 64 + fr, fq * 8), boff = lds_byte(wc * 32 + fr, fq * 8);
#define PG8_SA(b, h) (((b) * 2 + (h)) * HTB)
#define PG8_SB(b, h) ((4 + (b) * 2 + (h)) * HTB)
#define PG8_STAGE(bufoff, gbase, voff) do { _Pragma("unroll") for (int _i = 0; _i < 2; ++_i) \
        __builtin_amdgcn_global_load_lds((const unsigned*)((const char*)(gbase) + (voff)[_i]), (LAS unsigned*)(lds + (bufoff) + ldsw + _i * 8192), 16, 0, 0); } while (0)
#define PG8_LDA(dst, b, h) do { _Pragma("unroll") for (int m = 0; m < 4; ++m) _Pragma("unroll") for (int k = 0; k < 2; ++k) dst[m][k] = *(const LAS bf16x8*)(lds + PG8_SA(b, h) + aoff + m * 2048 + k * 1024); } while (0)
#define PG8_LDB(dst, b, h) do { _Pragma("unroll") for (int n = 0; n < 2; ++n) _Pragma("unroll") for (int k = 0; k < 2; ++k) dst[n][k] = *(const LAS bf16x8*)(lds + PG8_SB(b, h) + boff + n * 2048 + k * 1024); } while (0)
#define PG8_MMA(ai, bj, At, Bt) do { __builtin_amdgcn_s_setprio(1); _Pragma("unroll") for (int m = 0; m < 4; ++m) _Pragma("unroll") for (int n = 0; n < 2; ++n) _Pragma("unroll") for (int k = 0; k < 2; ++k) \
        acc[ai][bj][m][n] = __builtin_amdgcn_mfma_f32_16x16x32_bf16(Bt[n][k], At[m][k], acc[ai][bj][m][n], 0, 0, 0); __builtin_amdgcn_s_setprio(0); } while (0)
#define PG8_WAIT_V(n) asm volatile("s_waitcnt vmcnt(" #n ")" ::: "memory")
#define PG8_WAIT_L(n) asm volatile("s_waitcnt lgkmcnt(" #n ")" ::: "memory")
#define PG8_BAR __builtin_amdgcn_s_barrier()
#define PG8_SCHED __builtin_amdgcn_sched_barrier(0)
    Unit cur, nxt; int ui = 0;
    if (!S.next(0, cur)) return;
    f32x4 acc[2][2][4][2];
#pragma unroll
    for (int a = 0; a < 2; ++a)
#pragma unroll
        for (int b = 0; b < 2; ++b)
#pragma unroll
            for (int m = 0; m < 4; ++m)
#pragma unroll
                for (int n = 0; n < 2; ++n) acc[a][b][m][n] = (f32x4){0.f, 0.f, 0.f, 0.f};
    bf16x8 At[4][2], B0[2][2], B1[2][2];
    const char* cA = cur.a; const char* cB = cur.b;
    PG8_STAGE(PG8_SB(0, 0), cB, voffB); PG8_STAGE(PG8_SA(0, 0), cA, voffA); PG8_STAGE(PG8_SB(0, 1), cB + hstep, voffB); PG8_STAGE(PG8_SA(0, 1), cA + hstep, voffA);
    if (wr == 1) PG8_BAR;
    PG8_WAIT_V(4); PG8_BAR;
    PG8_STAGE(PG8_SB(1, 0), cB + kstep, voffB); PG8_STAGE(PG8_SA(1, 0), cA + kstep, voffA); PG8_STAGE(PG8_SB(1, 1), cB + hstep + kstep, voffB);
    PG8_WAIT_V(6); PG8_BAR;
    for (;;) {
        const bool has_next = S.next(ui + 1, nxt);
        const char* nA = has_next ? nxt.a : cA; const char* nB = has_next ? nxt.b : cB;
        for (int t = 0; t < nt; t += 2) {
            const bool last = (t == nt - 2);
            const char* a1 = cA + (size_t)(t + 1) * kstep;
            const char* a2 = last ? nA : cA + (size_t)(t + 2) * kstep; const char* b2 = last ? nB : cB + (size_t)(t + 2) * kstep;
            const char* a3 = a2 + kstep; const char* b3 = b2 + kstep;
            PG8_LDB(B0, 0, 0); PG8_SCHED; PG8_LDA(At, 0, 0); PG8_STAGE(PG8_SA(1, 1), a1 + hstep, voffA);
            PG8_WAIT_L(8); PG8_BAR; PG8_WAIT_L(0); PG8_MMA(0, 0, At, B0); PG8_BAR; PG8_SCHED;
            PG8_LDB(B1, 0, 1); PG8_STAGE(PG8_SB(0, 0), b2, voffB);
            PG8_BAR; PG8_WAIT_L(0); PG8_MMA(0, 1, At, B1); PG8_BAR;
            PG8_LDA(At, 0, 1); PG8_STAGE(PG8_SA(0, 0), a2, voffA);
            PG8_BAR; PG8_WAIT_L(0); PG8_MMA(1, 0, At, B0); PG8_BAR; PG8_SCHED;
            PG8_STAGE(PG8_SB(0, 1), b2 + hstep, voffB);
            PG8_WAIT_V(6); PG8_BAR; PG8_MMA(1, 1, At, B1); PG8_BAR;
            PG8_LDB(B0, 1, 0); PG8_SCHED; PG8_LDA(At, 1, 0); PG8_STAGE(PG8_SA(0, 1), a2 + hstep, voffA);
            PG8_WAIT_L(8); PG8_BAR; PG8_WAIT_L(0); PG8_MMA(0, 0, At, B0); PG8_BAR; PG8_SCHED;
            PG8_LDB(B1, 1, 1); PG8_STAGE(PG8_SB(1, 0), b3, voffB);
            PG8_BAR; PG8_WAIT_L(0); PG8_MMA(0, 1, At, B1); PG8_BAR;
            PG8_LDA(At, 1, 1); PG8_STAGE(PG8_SA(1, 0), a3, voffA);
            PG8_BAR; PG8_WAIT_L(0); PG8_MMA(1, 0, At, B0); PG8_BAR; PG8_SCHED;
            PG8_STAGE(PG8_SB(1, 1), b3 + hstep, voffB);
            PG8_WAIT_V(6); PG8_BAR; PG8_MMA(1, 1, At, B1); PG8_BAR;
        }
        E(acc, cur, wr, wc, fr, fq);
        if (!has_next) break;
#pragma unroll
        for (int a = 0; a < 2; ++a)
#pragma unroll
            for (int b = 0; b < 2; ++b)
#pragma unroll
                for (int m = 0; m < 4; ++m)
#pragma unroll
                    for (int n = 0; n < 2; ++n) acc[a][b][m][n] = (f32x4){0.f, 0.f, 0.f, 0.f};
        cur = nxt; cA = nA; cB = nB; ++ui;
    }
    PG8_WAIT_V(0);
    if (wr == 0) PG8_BAR;
    PG8_BAR;
#undef PG8_SA
#undef PG8_SB
#undef PG8_STAGE
#undef PG8_LDA
#undef PG8_LDB
#undef PG8_MMA
#undef PG8_WAIT_V
#undef PG8_WAIT_L
#undef PG8_BAR
#undef PG8_SCHED
}

struct EpiProj {
    static constexpr bool PERM = true;
    bf16 *sbq, *sbk, *sbv, *daq, *dak, *dav; const float* rope;
    __device__ __forceinline__ void operator()(const f32x4 (&acc)[2][2][4][2], const Unit& u, int wr, int wc, int fr, int fq) const {
        const int ty = u.pn >> 2;
        bf16* base = ty == 0 ? sbq : ty == 1 ? sbk : ty == 2 ? sbv : ty == 3 ? daq : ty == 4 ? dak : dav;
        const bool kv = (ty != 0 && ty != 3);
        const int bb = u.pm >> 4;
        const int rowadd = kv ? 64 * (bb + 1) : 0;
        const int row0 = u.pm * BM + wr * 64 + fr, col0 = (u.pn & 3) * BM + wc * 32 + 8 * fq;
        const bool rope_wave = (ty == 3 || ty == 4) && ((wc & 1) == 0);
#pragma unroll
        for (int ai = 0; ai < 2; ++ai)
#pragma unroll
            for (int m = 0; m < 4; ++m) {
                const int r = row0 + ai * HALF + m * 16;
                bf16* rowp = base + (size_t)(r + rowadd) * HW + col0;
                f32x4 cs0 = {1.f, 1.f, 1.f, 1.f}, cs1 = cs0, sn0 = {0.f, 0.f, 0.f, 0.f}, sn1 = sn0;
                if (rope_wave) { const float* rp = rope + (size_t)(NMETA + (r & (SEQ - 1))) * 16;
                    cs0 = *(const f32x4*)(rp); cs1 = *(const f32x4*)(rp + 4); sn0 = *(const f32x4*)(rp + 8); sn1 = *(const f32x4*)(rp + 12); }
#pragma unroll
                for (int bj = 0; bj < 2; ++bj) {
                    f32x4 v0 = acc[ai][bj][m][0], v1 = acc[ai][bj][m][1];
                    if (rope_wave) {
                        f32x4 o0, o1;
#pragma unroll
                        for (int j = 0; j < 4; ++j) { o0[j] = __shfl_xor(v0[j], 16); o1[j] = __shfl_xor(v1[j], 16); }
                        if (fq == 0) { v0 = v0 * cs0 - o0 * sn0; v1 = v1 * cs1 - o1 * sn1; }
                        else if (fq == 1) { v0 = v0 * cs0 + o0 * sn0; v1 = v1 * cs1 + o1 * sn1; }
                    }
                    v4u w; w.x = cvt_pk_bf16(v0[0], v0[1]); w.y = cvt_pk_bf16(v0[2], v0[3]); w.z = cvt_pk_bf16(v1[0], v1[1]); w.w = cvt_pk_bf16(v1[2], v1[3]);
                    *(v4u*)(rowp + bj * HALF) = w; } }
    }
};
struct EpiRes {
    static constexpr bool PERM = false;
    const float* x; float* out;
    __device__ __forceinline__ void operator()(const f32x4 (&acc)[2][2][4][2], const Unit& u, int wr, int wc, int fr, int fq) const {
        const int row0 = u.pm * BM + wr * 64 + fr, col0 = u.pn * BM + wc * 32 + 4 * fq;
#pragma unroll
        for (int ai = 0; ai < 2; ++ai)
#pragma unroll
            for (int m = 0; m < 4; ++m) { const size_t off = (size_t)(row0 + ai * HALF + m * 16) * DM + col0;
#pragma unroll
                for (int bj = 0; bj < 2; ++bj)
#pragma unroll
                    for (int n = 0; n < 2; ++n) { const f32x4 xv = *(const f32x4*)(x + off + bj * HALF + n * 16); *(f32x4*)(out + off + bj * HALF + n * 16) = xv + acc[ai][bj][m][n]; } }
    }
};
struct EpiSwiglu {
    static constexpr bool PERM = true;
    bf16* act; const float* bgu;
    __device__ __forceinline__ void operator()(const f32x4 (&acc)[2][2][4][2], const Unit& u, int wr, int wc, int fr, int fq) const {
        const int row0 = u.pm * BM + wr * 64 + fr, col0 = u.pn * HALF + wc * 32 + 8 * fq;
        const float* bg = bgu + (size_t)u.e * 4096 + col0;
        const f32x4 g0 = *(const f32x4*)(bg), g1 = *(const f32x4*)(bg + 4), u0 = *(const f32x4*)(bg + 2048), u1 = *(const f32x4*)(bg + 2052);
#pragma unroll
        for (int ai = 0; ai < 2; ++ai)
#pragma unroll
            for (int m = 0; m < 4; ++m) {
                bf16* rowp = act + (size_t)(row0 + ai * HALF + m * 16) * DM + col0;
                float o[8];
#pragma unroll
                for (int n = 0; n < 2; ++n)
#pragma unroll
                    for (int j = 0; j < 4; ++j) {
                        const float hg = acc[ai][0][m][n][j] + (n ? g1[j] : g0[j]), hu = acc[ai][1][m][n][j] + (n ? u1[j] : u0[j]);
                        const float gt = fminf(hg, 7.0f), up = fminf(fmaxf(hu, -7.0f), 7.0f);
                        const float sg = 1.0f / (1.0f + __expf(-1.702f * gt));
                        o[n * 4 + j] = (up + 1.0f) * gt * sg; }
                v4u w; w.x = cvt_pk_bf16(o[0], o[1]); w.y = cvt_pk_bf16(o[2], o[3]); w.z = cvt_pk_bf16(o[4], o[5]); w.w = cvt_pk_bf16(o[6], o[7]);
                *(v4u*)rowp = w; }
    }
};
struct EpiDown {
    static constexpr bool PERM = true;
    bf16* ys; const float* bdn;
    __device__ __forceinline__ void operator()(const f32x4 (&acc)[2][2][4][2], const Unit& u, int wr, int wc, int fr, int fq) const {
        const int row0 = u.pm * BM + wr * 64 + fr, col0 = u.pn * BM + wc * 32 + 8 * fq;
        const float* bp = bdn + (size_t)u.e * DM + col0;
        f32x4 bv[2][2];
#pragma unroll
        for (int bj = 0; bj < 2; ++bj)
#pragma unroll
            for (int n = 0; n < 2; ++n) bv[bj][n] = *(const f32x4*)(bp + bj * HALF + 4 * n);
#pragma unroll
        for (int ai = 0; ai < 2; ++ai)
#pragma unroll
            for (int m = 0; m < 4; ++m) { bf16* rowp = ys + (size_t)(row0 + ai * HALF + m * 16) * DM + col0;
#pragma unroll
                for (int bj = 0; bj < 2; ++bj) { const f32x4 v0 = acc[ai][bj][m][0] + bv[bj][0], v1 = acc[ai][bj][m][1] + bv[bj][1];
                    v4u w; w.x = cvt_pk_bf16(v0[0], v0[1]); w.y = cvt_pk_bf16(v0[2], v0[3]); w.z = cvt_pk_bf16(v1[0], v1[1]); w.w = cvt_pk_bf16(v1[2], v1[3]);
                    *(v4u*)(rowp + bj * HALF) = w; } }
    }
};
}

struct Args { const float* in[19]; float* out; unsigned char* ws; int ph_lo, ph_hi; };
enum { I_X = 0, I_META, I_GMIX, I_WIN, I_LQ1, I_LK1, I_LQ2, I_LK2, I_GSB, I_GDA, I_WOUT, I_GFFN, I_WR, I_BR, I_WGU, I_BGU, I_WDN, I_BDN, I_GFIN };
constexpr int NWAVES = 8;

__device__ __forceinline__ void p0_transpose_item(const float* W, int N, bf16* WT, int k0, int n0, int drow0, LAS float* scr, int lane) {
#pragma unroll 8
    for (int i = 0; i < 32; ++i) { const int kk = 2 * i + (lane >> 5); scr[kk * 33 + (lane & 31)] = W[(size_t)(k0 + kk) * N + n0 + (lane & 31)]; }
    LDS_WAIT(); asm volatile("" ::: "memory");
    const int c = lane & 7;
#pragma unroll
    for (int j = 0; j < 4; ++j) { const int n = (lane >> 3) + 8 * j; const LAS float* s = scr + (8 * c) * 33 + n;
        v4u o; o.x = pk2(s[0 * 33], s[1 * 33]); o.y = pk2(s[2 * 33], s[3 * 33]); o.z = pk2(s[4 * 33], s[5 * 33]); o.w = pk2(s[6 * 33], s[7 * 33]);
        *(v4u*)(WT + (size_t)(drow0 + n) * DM + k0 + 8 * c) = o; }
    LDS_WAIT(); asm volatile("" ::: "memory");
}
__device__ __forceinline__ void rms_row_to_bf16(const float* xrow, const float* g, bf16* orow, int lane) {
    const f32x4* xr = (const f32x4*)xrow + lane; const f32x4* gr = (const f32x4*)g + lane;
    f32x4 v[8]; float s = 0.f;
#pragma unroll
    for (int j = 0; j < 8; ++j) { v[j] = xr[64 * j]; s += (v[j].x * v[j].x + v[j].y * v[j].y) + (v[j].z * v[j].z + v[j].w * v[j].w); }
    const float rstd = 1.0f / sqrtf(wave_sum(s) * (1.f / DM) + RMS_EPS);
    v2u* o8 = (v2u*)orow + lane;
#pragma unroll
    for (int j = 0; j < 8; ++j) { const f32x4 gg = gr[64 * j]; v2u w; w.x = pk2(v[j].x * rstd * gg.x, v[j].y * rstd * gg.y); w.y = pk2(v[j].z * rstd * gg.z, v[j].w * rstd * gg.w); o8[64 * j] = w; }
}
__device__ __forceinline__ void sincos_rev(double t, float& s, float& c) {
    t -= __builtin_rint(t);
    const double x = t * 6.283185307179586476925286766559, x2 = x * x;
    double ts = x, ss = x, tc = 1.0, cc = 1.0;
#pragma unroll
    for (int k = 1; k <= 14; ++k) { ts *= -x2 / (double)((2 * k) * (2 * k + 1)); ss += ts; tc *= -x2 / (double)((2 * k - 1) * (2 * k)); cc += tc; }
    s = (float)ss; c = (float)cc;
}

__device__ __forceinline__ float rope_inv_freq(int j) {
    return j == 0 ? 1.0f : j == 1 ? 0.1939227432012558f : j == 2 ? 0.03760603070259094f : j == 3 ? 0.007292664609849453f : j == 4 ? 0.0014142135623842478f : j == 5 ? 0.00027424818836152554f : j == 6 ? 5.318296098266728e-05f : 1.0313386155758053e-05f;
}
__device__ __forceinline__ void phase0(const Args& a, LAS unsigned char* lds, int vcu, int G, int tid, int lane, int wave) {
    unsigned char* ws = a.ws;
    for (int unit = vcu; unit < 64; unit += G) {
        LAS float* um = (LAS float*)lds;
        for (int rr = 0; rr < 2; ++rr) { const int r = wave * 2 + rr;
            const f32x4* xr = (const f32x4*)(a.in[I_META] + (size_t)r * DM) + lane; const f32x4* gr = (const f32x4*)a.in[I_GMIX] + lane;
            f32x4 v[8]; float s = 0.f;
#pragma unroll
            for (int j = 0; j < 8; ++j) { v[j] = xr[64 * j]; s += (v[j].x * v[j].x + v[j].y * v[j].y) + (v[j].z * v[j].z + v[j].w * v[j].w); }
            const float rstd = 1.0f / sqrtf(wave_sum(s) * (1.f / DM) + RMS_EPS);
#pragma unroll
            for (int j = 0; j < 8; ++j) { const f32x4 gg = gr[64 * j]; *(LAS f32x4*)(um + r * DM + 4 * (lane + 64 * j)) = v[j] * rstd * gg; } }
        __syncthreads();
        const int grp = unit >> 4, cbase = (unit & 15) * 64;
        const int scol = (grp == 0 ? 1024 : grp == 1 ? 2048 : grp == 2 ? 4096 : 5120) + cbase + lane;
        float acc[16];
#pragma unroll
        for (int r = 0; r < 16; ++r) acc[r] = 0.f;
        const float* wp = a.in[I_WIN] + (size_t)(wave * 256) * INCOLS + scol;
#pragma unroll 4
        for (int k = 0; k < 256; ++k) { const float w = wp[(size_t)k * INCOLS];
#pragma unroll
            for (int r = 0; r < 16; ++r) acc[r] += um[r * DM + wave * 256 + k] * w; }
        __syncthreads();
        LAS float* red = (LAS float*)lds;
#pragma unroll
        for (int r = 0; r < 16; ++r) red[(wave * 16 + r) * 64 + lane] = acc[r];
        __syncthreads();
        LAS float* res = red + 8 * 16 * 64;
        for (int o = tid; o < 1024; o += 512) { float s = 0.f;
#pragma unroll
            for (int w8 = 0; w8 < 8; ++w8) s += red[(w8 * 16 + (o >> 6)) * 64 + (o & 63)];
            res[o] = s; }
        __syncthreads();
        bf16* dst = (bf16*)(ws + (grp == 0 ? WS_SBK : grp == 1 ? WS_SBV : grp == 2 ? WS_DAK : WS_DAV));
        const float* rope = (const float*)(ws + WS_ROPE);
        for (int o = tid; o < 1024; o += 512) { const int r = o >> 6, c = o & 63; float v = res[o];
            if (grp == 2) { const int d = c;
                if (d < 16) { float sn, cs; { const float ang = (float)r * rope_inv_freq(d & 7); sincos_rev((double)ang * 0.15915494309189533576888376337251, sn, cs); }
                    const float other = res[r * 64 + (d ^ 8)];
                    v = (d < 8) ? v * cs - other * sn : v * cs + other * sn; } }
            const unsigned short bv = (unsigned short)f2bf(v);
#pragma unroll
            for (int b = 0; b < BATCH; ++b) dst[(size_t)(b * LPB + KVPAD + r) * HW + cbase + c] = bv; }
        (void)rope;
        __syncthreads();
    }
    { const int gt = vcu * 512 + tid, NT = G * 512;
      for (int i = gt; i < 4 * BATCH * KVPAD * (HW / 8); i += NT) { const int t = i / (BATCH * KVPAD * (HW / 8)), rem = i % (BATCH * KVPAD * (HW / 8)), b = rem / (KVPAD * (HW / 8)), rr = (rem / (HW / 8)) % KVPAD, c8 = rem % (HW / 8);
          bf16* dst = (bf16*)(ws + (t == 0 ? WS_SBK : t == 1 ? WS_SBV : t == 2 ? WS_DAK : WS_DAV));
          *(v4u*)(dst + (size_t)(b * LPB + rr) * HW + c8 * 8) = (v4u){0u, 0u, 0u, 0u}; }
      float* rope = (float*)(ws + WS_ROPE);
      for (int i = gt; i < (NMETA + SEQ) * 8; i += NT) { const int pos = i >> 3, j = i & 7;
          const float ang = (float)pos * rope_inv_freq(j); float sn, cs; sincos_rev((double)ang * 0.15915494309189533576888376337251, sn, cs);
          rope[pos * 16 + j] = cs; rope[pos * 16 + 8 + j] = sn; }
      if (vcu == 0 && wave == 0) { const float d1 = wave_sum(a.in[I_LQ1][lane] * a.in[I_LK1][lane]), d2 = wave_sum(a.in[I_LQ2][lane] * a.in[I_LK2][lane]);
          if (lane == 0) ((float*)(ws + WS_CTL))[CW_LAM] = expf(d1) - expf(d2) + LAM_INIT; } }
    { LAS float* scr = (LAS float*)(lds + wave * 16384);
      const int gw = vcu * NWAVES + wave, NGW = G * NWAVES;
      constexpr int I_IN = 32 * (INCOLS / 32), I_OUT = 32 * (DM / 32), I_GU1 = 32 * (4096 / 32), I_DN1 = 32 * (DM / 32);
      constexpr int NITEMS = I_IN + I_OUT + NEXP * I_GU1 + NEXP * I_DN1;
      for (int it = gw; it < NITEMS; it += NGW) {
          int r = it;
          if (r < I_IN) { const int nblk = INCOLS / 32, kb = r / nblk, nb = r % nblk; p0_transpose_item(a.in[I_WIN], INCOLS, (bf16*)(ws + WS_WIN), 64 * kb, 32 * nb, 32 * nb, scr, lane); continue; } r -= I_IN;
          if (r < I_OUT) { const int nblk = DM / 32, kb = r / nblk, nb = r % nblk; p0_transpose_item(a.in[I_WOUT], DM, (bf16*)(ws + WS_WOUT), 64 * kb, 32 * nb, 32 * nb, scr, lane); continue; } r -= I_OUT;
          if (r < NEXP * I_GU1) { const int e = r / I_GU1, q = r % I_GU1, nblk = 4096 / 32, kb = q / nblk, nb = q % nblk, n0 = 32 * nb;
              const int drow0 = n0 < 2048 ? (n0 >> 7) * 256 + (n0 & 127) : ((n0 - 2048) >> 7) * 256 + 128 + ((n0 - 2048) & 127);
              p0_transpose_item(a.in[I_WGU] + (size_t)e * DM * 4096, 4096, (bf16*)(ws + WS_WGU) + (size_t)e * 4096 * DM, 64 * kb, n0, drow0, scr, lane); continue; } r -= NEXP * I_GU1;
          { const int e = r / I_DN1, q = r % I_DN1, nblk = DM / 32, kb = q / nblk, nb = q % nblk;
              p0_transpose_item(a.in[I_WDN] + (size_t)e * DM * DM, DM, (bf16*)(ws + WS_WDN) + (size_t)e * DM * DM, 64 * kb, 32 * nb, 32 * nb, scr, lane); }
      }
      for (int m = gw; m < NTOK; m += NGW) rms_row_to_bf16(a.in[I_X] + (size_t)m * DM, a.in[I_GMIX], (bf16*)(ws + WS_U) + (size_t)m * DM, lane);
    }
}

__device__ __forceinline__ void phase4(const Args& a, LAS unsigned char* lds, int vcu, int G, int lane, int wave) {
    unsigned char* ws = a.ws;
    LAS float* ub = (LAS float*)(lds + wave * 16384);
    const int gw = vcu * NWAVES + wave, NGW = G * NWAVES;
    int* r_e = (int*)(ws + WS_ROUTE); float* r_g = (float*)(ws + WS_ROUTE + 256 * 1024); int* r_rank = (int*)(ws + WS_ROUTE + 512 * 1024);
    unsigned* cnt = (unsigned*)(ws + WS_CTL) + CW_CNT;
    const float* wr_ = a.in[I_WR];
    for (int pair = gw; pair < NTOK / 2; pair += NGW) {
#pragma unroll
        for (int rr = 0; rr < 2; ++rr) { const int m = pair * 2 + rr;
            const f32x4* xr = (const f32x4*)(a.out + (size_t)m * DM) + lane; const f32x4* gr = (const f32x4*)a.in[I_GFFN] + lane;
            f32x4 v[8]; float s = 0.f;
#pragma unroll
            for (int j = 0; j < 8; ++j) { v[j] = xr[64 * j]; s += (v[j].x * v[j].x + v[j].y * v[j].y) + (v[j].z * v[j].z + v[j].w * v[j].w); }
            const float rstd = 1.0f / sqrtf(wave_sum(s) * (1.f / DM) + RMS_EPS);
            v2u* o8 = (v2u*)((bf16*)(ws + WS_U2) + (size_t)m * DM) + lane;
#pragma unroll
            for (int j = 0; j < 8; ++j) { const f32x4 gg = gr[64 * j]; const f32x4 uu = v[j] * rstd * gg;
                v2u w; w.x = pk2(uu.x, uu.y); w.y = pk2(uu.z, uu.w); o8[64 * j] = w;
                *(LAS f32x4*)(ub + rr * DM + 4 * (lane + 64 * j)) = uu; } }
        LDS_WAIT(); asm volatile("" ::: "memory");
        const int e = lane & 31, rs = lane >> 5;
        float acc0 = 0.f, acc1 = 0.f, acc2 = 0.f, acc3 = 0.f;
        const LAS float* up = ub + rs * DM;
#pragma unroll 2
        for (int k = 0; k < DM; k += 4) { const f32x4 uu = *(const LAS f32x4*)(up + k);
            acc0 += uu.x * wr_[(k + 0) * NEXP + e]; acc1 += uu.y * wr_[(k + 1) * NEXP + e]; acc2 += uu.z * wr_[(k + 2) * NEXP + e]; acc3 += uu.w * wr_[(k + 3) * NEXP + e]; }
        const float logit = ((acc0 + acc1) + (acc2 + acc3)) + a.in[I_BR][e];
        bool taken = false; float sv[4]; int si[4];
#pragma unroll
        for (int r = 0; r < 4; ++r) { float bv = taken ? -3.0e38f : logit; int bi = e;
#pragma unroll
            for (int off = 1; off < 32; off <<= 1) { const float ov = __shfl_xor(bv, off); const int oi = __shfl_xor(bi, off); if (ov > bv || (ov == bv && oi < bi)) { bv = ov; bi = oi; } }
            sv[r] = bv; si[r] = bi; if (e == bi) taken = true; }
        const float e1 = __expf(sv[1] - sv[0]), e2 = __expf(sv[2] - sv[0]), e3 = __expf(sv[3] - sv[0]), inv = 1.0f / (1.0f + e1 + e2 + e3);
        const int tok = pair * 2 + rs;
#pragma unroll
        for (int r = 0; r < 4; ++r) if (e == r) { const float gte = (r == 0 ? 1.0f : r == 1 ? e1 : r == 2 ? e2 : e3) * inv;
            const unsigned rank = __hip_atomic_fetch_add(cnt + 64 * si[r], 1u, __ATOMIC_RELAXED, __HIP_MEMORY_SCOPE_AGENT);
            r_e[tok * 4 + r] = si[r]; r_g[tok * 4 + r] = gte; r_rank[tok * 4 + r] = (int)rank; }
        LDS_WAIT(); asm volatile("" ::: "memory");
    }
}
__device__ __forceinline__ void phase4b(const Args& a, LAS unsigned char* lds, int vcu, int G, int tid, int lane, int wave) {
    unsigned char* ws = a.ws;
    unsigned* ctl = (unsigned*)(ws + WS_CTL);
    LAS int* tp = (LAS int*)(lds + MISC_OFF + 1024);
    if (tid == 0) { int s = 0; for (int e = 0; e < NEXP; ++e) { tp[e] = s; const unsigned c = __hip_atomic_load(ctl + CW_CNT + 64 * e, __ATOMIC_RELAXED, __HIP_MEMORY_SCOPE_AGENT); s += (int)((c + 255u) >> 8); } tp[NEXP] = s; }
    __syncthreads();
    if (vcu == 0) { const int total = tp[NEXP]; if (tid == 0) ctl[CW_NTILES] = (unsigned)total;
        for (int e = 0; e < NEXP; ++e) { const int lo = tp[e], hi = tp[e + 1]; for (int t = lo + tid; t < hi; t += 512) ctl[CW_TILE_E + t] = (unsigned)e; } }
    const int gw = vcu * NWAVES + wave, NGW = G * NWAVES;
    const int* r_e = (const int*)(ws + WS_ROUTE); const int* r_rank = (const int*)(ws + WS_ROUTE + 512 * 1024);
    for (int tok = gw; tok < NTOK; tok += NGW) {
        const v4u* src = (const v4u*)((const bf16*)(ws + WS_U2) + (size_t)tok * DM) + lane;
        v4u v[4];
#pragma unroll
        for (int j = 0; j < 4; ++j) v[j] = src[64 * j];
#pragma unroll
        for (int r = 0; r < 4; ++r) { const int e = r_e[tok * 4 + r], rank = r_rank[tok * 4 + r]; const size_t pos = (size_t)tp[e] * 256 + rank;
            v4u* dst = (v4u*)((bf16*)(ws + WS_XS) + pos * DM) + lane;
#pragma unroll
            for (int j = 0; j < 4; ++j) dst[64 * j] = v[j]; }
    }
}
__device__ __forceinline__ void phase7(const Args& a, LAS unsigned char* lds, int vcu, int G, int tid, int lane, int wave) {
    unsigned char* ws = a.ws;
    unsigned* ctl = (unsigned*)(ws + WS_CTL);
    LAS int* tp = (LAS int*)(lds + MISC_OFF + 1024);
    if (tid == 0) { int s = 0; for (int e = 0; e < NEXP; ++e) { tp[e] = s; const unsigned c = __hip_atomic_load(ctl + CW_CNT + 64 * e, __ATOMIC_RELAXED, __HIP_MEMORY_SCOPE_AGENT); s += (int)((c + 255u) >> 8); } tp[NEXP] = s; }
    __syncthreads();
    const int gw = vcu * NWAVES + wave, NGW = G * NWAVES;
    const int* r_e = (const int*)(ws + WS_ROUTE); const float* r_g = (const float*)(ws + WS_ROUTE + 256 * 1024); const int* r_rank = (const int*)(ws + WS_ROUTE + 512 * 1024);
    for (int tok = gw; tok < NTOK; tok += NGW) {
        f32x4* xr = (f32x4*)(a.out + (size_t)tok * DM) + lane;
        f32x4 v[8];
#pragma unroll
        for (int j = 0; j < 8; ++j) v[j] = xr[64 * j];
#pragma unroll
        for (int r = 0; r < 4; ++r) { const int e = r_e[tok * 4 + r], rank = r_rank[tok * 4 + r]; const float gte = r_g[tok * 4 + r]; const size_t pos = (size_t)tp[e] * 256 + rank;
            const v2u* yr = (const v2u*)((const bf16*)(ws + WS_YS) + pos * DM) + lane;
#pragma unroll
            for (int j = 0; j < 8; ++j) { const v2u w = yr[64 * j]; v[j].x += gte * bflo(w.x); v[j].y += gte * bfhi(w.x); v[j].z += gte * bflo(w.y); v[j].w += gte * bfhi(w.y); } }
        float s = 0.f;
#pragma unroll
        for (int j = 0; j < 8; ++j) s += (v[j].x * v[j].x + v[j].y * v[j].y) + (v[j].z * v[j].z + v[j].w * v[j].w);
        const float rstd = 1.0f / sqrtf(wave_sum(s) * (1.f / DM) + RMS_EPS);
        const f32x4* gr = (const f32x4*)a.in[I_GFIN] + lane;
#pragma unroll
        for (int j = 0; j < 8; ++j) xr[64 * j] = v[j] * rstd * gr[64 * j];
    }
}

__global__ void __launch_bounds__(256) naive_sb(const bf16* Q, const bf16* Kp, const bf16* Vp, const float* g, bf16* mixed) {
    const int lane = threadIdx.x & 63, gw = blockIdx.x * 4 + (threadIdx.x >> 6);
    const int i = gw % SEQ, h = (gw / SEQ) % 8, b = gw / (SEQ * 8), m = b * SEQ + i;
    const unsigned qw = *(const unsigned*)(Q + (size_t)m * HW + h * 128 + 2 * lane);
    const float q0 = bflo(qw), q1 = bfhi(qw);
    float o0 = 0.f, o1 = 0.f, carry = 0.f;
    for (int p = 64 + i - 1; p >= KVPAD; --p) {
        const size_t ro = (size_t)(b * LPB + p) * HW + h * 128 + 2 * lane;
        const unsigned kw = *(const unsigned*)(Kp + ro), vw = *(const unsigned*)(Vp + ro);
        const float z = wave_sum(q0 * bflo(kw) + q1 * bfhi(kw)) * 0.08838834764831845f;
        const float sp = fmaxf(z, 0.f) + log1pf(expf(-fabsf(z)));
        const float w = expf(z - sp + carry); carry -= sp;
        o0 += w * bflo(vw); o1 += w * bfhi(vw);
    }
    const float r = 1.0f / sqrtf(wave_sum(o0 * o0 + o1 * o1) * (1.f / 128.f) + RMS_EPS);
    *(unsigned*)(mixed + (size_t)m * DM + h * 128 + 2 * lane) = pk2(o0 * r * g[h * 128 + 2 * lane], o1 * r * g[h * 128 + 2 * lane + 1]);
}
__global__ void __launch_bounds__(256) naive_da(const bf16* Q, const bf16* Kp, const bf16* Vp, const float* g, const float* lamp, bf16* mixed) {
    const int lane = threadIdx.x & 63, gw = blockIdx.x * 4 + (threadIdx.x >> 6);
    const int i = gw % SEQ, h = (gw / SEQ) % 8, b = gw / (SEQ * 8), m = b * SEQ + i;
    const float qa = bf2f(Q[(size_t)m * HW + h * 128 + lane]), qb = bf2f(Q[(size_t)m * HW + h * 128 + 64 + lane]);
    const int c = 1 + i / 64, pend = 64 + 64 * c;
    float m1 = -3.0e38f, m2 = -3.0e38f, l1 = 0.f, l2 = 0.f, a0 = 0.f, a1 = 0.f, b0 = 0.f, b1 = 0.f;
    for (int p = KVPAD; p < pend; ++p) {
        const size_t ro = (size_t)(b * LPB + p) * HW + h * 128;
        const float s1 = wave_sum(qa * bf2f(Kp[ro + lane])) * 0.125f, s2 = wave_sum(qb * bf2f(Kp[ro + 64 + lane])) * 0.125f;
        const unsigned vw = *(const unsigned*)(Vp + ro + 2 * lane); const float v0 = bflo(vw), v1 = bfhi(vw);
        { const float mn = fmaxf(m1, s1), al = expf(m1 - mn), pp = expf(s1 - mn); l1 = l1 * al + pp; a0 = a0 * al + pp * v0; a1 = a1 * al + pp * v1; m1 = mn; }
        { const float mn = fmaxf(m2, s2), al = expf(m2 - mn), pp = expf(s2 - mn); l2 = l2 * al + pp; b0 = b0 * al + pp * v0; b1 = b1 * al + pp * v1; m2 = mn; }
    }
    const float lam = lamp[0];
    const float o0 = a0 / l1 - lam * b0 / l2, o1 = a1 / l1 - lam * b1 / l2;
    const float r = 1.0f / sqrtf(wave_sum(o0 * o0 + o1 * o1) * (1.f / 128.f) + RMS_EPS) * (1.0f - LAM_INIT);
    *(unsigned*)(mixed + (size_t)m * DM + 1024 + h * 128 + 2 * lane) = pk2(o0 * r * g[h * 128 + 2 * lane], o1 * r * g[h * 128 + 2 * lane + 1]);
}

enum { PH_PRO = 0, PH_INPROJ, PH_ATTN, PH_OUTPROJ, PH_ROUTE, PH_SCATTER, PH_GATEUP, PH_DOWN, PH_FINAL, PH_N };
__global__ void __launch_bounds__(NWAVES * 64, 2) fwd(Args args) {
    extern __shared__ __attribute__((aligned(16))) unsigned char lds_raw[];
    LAS unsigned char* lds = (LAS unsigned char*)lds_raw;
    const int tid = threadIdx.x, lane = tid & 63, wave = __builtin_amdgcn_readfirstlane(tid >> 6);
    const int G = gridDim.x; const int bx = blockIdx.x; const int vcu = (G % 8 == 0) ? (bx % 8) * (G / 8) + bx / 8 : bx;
    unsigned char* ws = args.ws;
    unsigned* ctl = (unsigned*)(ws + WS_CTL);
    volatile LAS unsigned* MISC = (volatile LAS unsigned*)(lds + MISC_OFF);
    if (tid < 64) MISC[tid] = 0u;
    __syncthreads();
    XcdBarrier bar; bar.bar = ctl + CW_BAR; bar.x = 0; bar.st = MISC + 8;
    const int lo = args.ph_lo, hi = args.ph_hi;
    if (hi - lo > 1) bar = xcd_barrier_post(ctl + CW_BAR, MISC + 8);
#define IN(k) (lo <= (k) && (k) < hi)
#define SEAM(k) do { if (IN(k) && IN((k) + 1)) xcd_barrier(bar); } while (0)

    if (IN(PH_PRO)) { phase0(args, lds, vcu, G, tid, lane, wave); SEAM(PH_PRO); }
    if (IN(PH_INPROJ)) {
        pg8::DenseOrder S; S.init((const bf16*)(ws + WS_U), (const bf16*)(ws + WS_WIN), NTOK, INCOLS, G, bx);
        pg8::EpiProj E{(bf16*)(ws + WS_SBQ), (bf16*)(ws + WS_SBK), (bf16*)(ws + WS_SBV), (bf16*)(ws + WS_DAQ), (bf16*)(ws + WS_DAK), (bf16*)(ws + WS_DAV), (const float*)(ws + WS_ROPE)};
        pg8::gemm_phase<pg8::EpiProj, pg8::DenseOrder>(lds, S, E);
        SEAM(PH_INPROJ);
    }
    if (IN(PH_ATTN)) { SEAM(PH_ATTN); }
    if (IN(PH_OUTPROJ)) {
        pg8::DenseOrder S; S.init((const bf16*)(ws + WS_MIX), (const bf16*)(ws + WS_WOUT), NTOK, DM, G, bx);
        pg8::EpiRes E{args.in[I_X], args.out};
        pg8::gemm_phase<pg8::EpiRes, pg8::DenseOrder>(lds, S, E);
        SEAM(PH_OUTPROJ);
    }
    if (IN(PH_ROUTE)) { phase4(args, lds, vcu, G, lane, wave); SEAM(PH_ROUTE); }
    if (IN(PH_SCATTER)) { phase4b(args, lds, vcu, G, tid, lane, wave); SEAM(PH_SCATTER); }
    if (IN(PH_GATEUP)) {
        const int ntiles = (int)__hip_atomic_load(ctl + CW_NTILES, __ATOMIC_RELAXED, __HIP_MEMORY_SCOPE_AGENT);
        pg8::MoeOrder S; S.init((const bf16*)(ws + WS_XS), (const bf16*)(ws + WS_WGU), __builtin_amdgcn_readfirstlane(ntiles), 4096, ctl + CW_TILE_E, G, bx);
        pg8::EpiSwiglu E{(bf16*)(ws + WS_ACT), args.in[I_BGU]};
        pg8::gemm_phase<pg8::EpiSwiglu, pg8::MoeOrder>(lds, S, E);
        SEAM(PH_GATEUP);
    }
    if (IN(PH_DOWN)) {
        const int ntiles = (int)__hip_atomic_load(ctl + CW_NTILES, __ATOMIC_RELAXED, __HIP_MEMORY_SCOPE_AGENT);
        pg8::MoeOrder S; S.init((const bf16*)(ws + WS_ACT), (const bf16*)(ws + WS_WDN), __builtin_amdgcn_readfirstlane(ntiles), DM, ctl + CW_TILE_E, G, bx);
        pg8::EpiDown E{(bf16*)(ws + WS_YS), args.in[I_BDN]};
        pg8::gemm_phase<pg8::EpiDown, pg8::MoeOrder>(lds, S, E);
        SEAM(PH_DOWN);
    }
    if (IN(PH_FINAL)) { phase7(args, lds, vcu, G, tid, lane, wave); }
#undef IN
#undef SEAM
}

extern "C" void kernel_launch(void* const* d_in, const int* in_sizes, int n_in, void* d_out, int out_size, void* d_ws, size_t ws_size, hipStream_t stream) {
    static int grid = 0;
    if (grid == 0) {
        if (n_in != 19 || out_size != NTOK * DM || ws_size < WS_END) { fprintf(stderr, "kernel_launch: unexpected shapes (n_in %d out %d ws %zu)\n", n_in, out_size, ws_size); grid = -1; return; }
        int dev = 0, cus = 0, per_cu = 0;
        if (hipGetDevice(&dev) != hipSuccess || hipDeviceGetAttribute(&cus, hipDeviceAttributeMultiprocessorCount, dev) != hipSuccess) { grid = -1; return; }
        if (hipFuncSetAttribute((const void*)fwd, hipFuncAttributeMaxDynamicSharedMemorySize, LDS_BYTES) != hipSuccess) { fprintf(stderr, "kernel_launch: hipFuncSetAttribute failed\n"); grid = -1; return; }
        if (hipOccupancyMaxActiveBlocksPerMultiprocessor(&per_cu, (const void*)fwd, NWAVES * 64, LDS_BYTES) != hipSuccess || per_cu < 1) { fprintf(stderr, "kernel_launch: occupancy query says %d\n", per_cu); }
        (void)hipGetLastError();
        grid = cus;
    }
    if (grid < 0) return;
    (void)in_sizes;
    (void)hipMemsetAsync((char*)d_ws + WS_CTL, 0, CTL_ZERO_BYTES, stream);
    Args a{};
    for (int i = 0; i < 19; ++i) a.in[i] = (const float*)d_in[i];
    a.out = (float*)d_out; a.ws = (unsigned char*)d_ws;
    unsigned char* ws = (unsigned char*)d_ws;
#if N_LAUNCH_MODE == 1
    a.ph_lo = 0; a.ph_hi = PH_N;
    hipLaunchKernelGGL(fwd, dim3(grid), dim3(NWAVES * 64), LDS_BYTES, stream, a);
#else
    for (int ph = 0; ph < PH_N; ++ph) {
        if (ph == PH_ATTN) {
            hipLaunchKernelGGL(naive_sb, dim3(BATCH * 8 * SEQ / 4), dim3(256), 0, stream, (const bf16*)(ws + WS_SBQ), (const bf16*)(ws + WS_SBK), (const bf16*)(ws + WS_SBV), (const float*)d_in[I_GSB], (bf16*)(ws + WS_MIX));
            hipLaunchKernelGGL(naive_da, dim3(BATCH * 8 * SEQ / 4), dim3(256), 0, stream, (const bf16*)(ws + WS_DAQ), (const bf16*)(ws + WS_DAK), (const bf16*)(ws + WS_DAV), (const float*)d_in[I_GDA], (const float*)(ws + WS_CTL) + CW_LAM, (bf16*)(ws + WS_MIX));
            continue;
        }
        a.ph_lo = ph; a.ph_hi = ph + 1;
        hipLaunchKernelGGL(fwd, dim3(grid), dim3(NWAVES * 64), LDS_BYTES, stream, a);
    }
#endif
    const hipError_t le = hipPeekAtLastError();
    if (le != hipSuccess) fprintf(stderr, "kernel_launch: launch failed: %s\n", hipGetErrorName(le));
}
```

```cpp
#include <hip/hip_runtime.h>
#include <cstdio>
#include <cstdint>

#ifndef REP_PRO
#define REP_PRO 1
#endif
#ifndef REP_INPROJ
#define REP_INPROJ 1
#endif
#ifndef REP_ATTN
#define REP_ATTN 1
#endif
#ifndef REP_GU
#define REP_GU 1
#endif
#ifndef REP_DOWN
#define REP_DOWN 1
#endif
#ifndef N_LAUNCH_MODE
#define N_LAUNCH_MODE 1
#endif

constexpr int BATCH = 4, SEQ = 4096, DM = 2048, NTOK = BATCH * SEQ;
constexpr int NMETA = 16, KVPAD = 48, LPB = 4160;
constexpr int HW = 1024;
constexpr int INCOLS = 6144;
constexpr int NEXP = 32, TOPK = 4;
constexpr int MAXTILES = 288, NPADROWS = MAXTILES * 256;
constexpr float RMS_EPS = 1e-5f;
constexpr float LAM_INIT = 0.2f;

constexpr size_t MiB = 1u << 20;
constexpr size_t WS_CTL = 0, CTL_ZERO_BYTES = 1 * MiB;
constexpr size_t WS_ROPE = 1 * MiB;
constexpr size_t WS_WIN = 2 * MiB;
constexpr size_t WS_WOUT = 26 * MiB;
constexpr size_t WS_U = 34 * MiB;
constexpr size_t WS_SBQ = 98 * MiB, WS_DAQ = 130 * MiB;
constexpr size_t WS_SBK = 162 * MiB, WS_SBV = 195 * MiB, WS_DAK = 228 * MiB, WS_DAV = 261 * MiB;
constexpr size_t WS_MIX = 294 * MiB;
constexpr size_t WS_U2 = 358 * MiB;
constexpr size_t WS_ROUTE = 422 * MiB;
constexpr size_t WS_ELIST = 424 * MiB;
constexpr size_t WS_WG = 1 * MiB + 512 * 1024;
constexpr size_t WS_ACT = 712 * MiB;
constexpr size_t WS_YS = 1000 * MiB;
constexpr size_t WS_WGU = 1288 * MiB;
constexpr size_t WS_WDN = 1800 * MiB;
constexpr size_t WS_END = 2056 * MiB;
constexpr int CW_TMO = 0, CW_LAM = 16, CW_NTILES = 32, CW_BAR = 4096, CW_CNT = 8192  , CW_TILE_E = 12288  , CW_QUEUE = 16384  ;

constexpr int LDS_BYTES = 163840;
constexpr int MISC_OFF = 131072;
constexpr int TE_OFF = MISC_OFF + 4608;
constexpr int CNT_OFF = MISC_OFF + 1280;
constexpr int IDX_OFF = MISC_OFF + 8192;
constexpr int IDX_TILES = 48;
constexpr int TICK_OFF = MISC_OFF + 7168;

#define GAS __attribute__((address_space(1)))
#define LAS __attribute__((address_space(3)))
typedef unsigned short bf16;
typedef unsigned v4u __attribute__((ext_vector_type(4)));
typedef unsigned v2u __attribute__((ext_vector_type(2)));
typedef float f32x4 __attribute__((ext_vector_type(4)));
typedef float f32x16 __attribute__((ext_vector_type(16)));
typedef short bf16x8 __attribute__((ext_vector_type(8)));
#define LDS_WAIT() asm volatile("s_waitcnt lgkmcnt(0)" ::: "memory")
#define VM_WAIT() asm volatile("s_waitcnt vmcnt(0)" ::: "memory")

__device__ __forceinline__ unsigned f2bf(float f) { unsigned u = __builtin_bit_cast(unsigned, f); return (u + 0x7fffu + ((u >> 16) & 1u)) >> 16; }
__device__ __forceinline__ unsigned pk2(float lo, float hi) { return f2bf(lo) | (f2bf(hi) << 16); }
__device__ __forceinline__ float bf2f(unsigned short b) { return __builtin_bit_cast(float, (unsigned)b << 16); }
__device__ __forceinline__ float bflo(unsigned w) { return __builtin_bit_cast(float, w << 16); }
__device__ __forceinline__ float bfhi(unsigned w) { return __builtin_bit_cast(float, w & 0xffff0000u); }
typedef __bf16 bf16x2_t __attribute__((ext_vector_type(2)));
typedef float f32x2_t __attribute__((ext_vector_type(2)));
__device__ __forceinline__ unsigned cvt2bf(float lo, float hi) { const f32x2_t v = {lo, hi}; const bf16x2_t r = __builtin_convertvector(v, bf16x2_t); return __builtin_bit_cast(unsigned, r); }
__device__ __forceinline__ float wave_sum(float v) {
#pragma unroll
    for (int o = 1; o < 64; o <<= 1) v += __shfl_xor(v, o);
    return v;
}

#define XB_TMO      128
#define XB_XCNT(j)  (256  + 64 * (j))
#define XB_XSUB(j)  (1280 + 64 * (j))
#define XB_XGEN(j)  (2304 + 64 * (j))
#define XB_TOP      3328
#define XB_TOPGEN   3392
#define XCD_BAR_WORDS 3456
#define XB_SPIN_CAP (1u << 22)
__device__ __forceinline__ unsigned xb_ld(unsigned* p)              { return __hip_atomic_load(p, __ATOMIC_RELAXED, __HIP_MEMORY_SCOPE_AGENT); }
__device__ __forceinline__ unsigned xb_add(unsigned* p, unsigned v) { return __hip_atomic_fetch_add(p, v, __ATOMIC_RELAXED, __HIP_MEMORY_SCOPE_AGENT); }
__device__ __forceinline__ unsigned xb_xcc_id() { return (unsigned)__builtin_amdgcn_s_getreg((3 << 11) | 20) & 0xFu; }
#define XB_SPIN(cond, bar) do { unsigned _sp = 0; while (cond) { __builtin_amdgcn_s_sleep(1); \
    if ((++_sp & 255u) == 0u) { if (xb_ld(&(bar)[XB_TMO])) break; if (_sp > XB_SPIN_CAP) { atomicAdd(&(bar)[XB_TMO], 1u); break; } } } } while (0)
struct XcdBarrier { unsigned* bar; unsigned x; volatile LAS unsigned* st; };
__device__ __forceinline__ XcdBarrier xcd_barrier_post(unsigned* bar, volatile LAS unsigned* st) {
    XcdBarrier b; b.bar = bar; b.x = xb_xcc_id(); b.st = st;
    if (threadIdx.x == 0) (void)xb_add(&bar[XB_XCNT(b.x)], 1u);
    return b;
}
__device__ __forceinline__ void xcd_barrier_complete(unsigned* bar, unsigned x, unsigned& nloc, unsigned& nx) {
    const unsigned G = gridDim.x * gridDim.y * gridDim.z;
    unsigned sum, cnt, mine, sp = 0u;
    for (;;) {
        sum = 0u; cnt = 0u; mine = 0u;
#pragma unroll
        for (unsigned j = 0; j < 16; ++j) { const unsigned c = xb_ld(&bar[XB_XCNT(j)]); sum += c; cnt += (c > 0u) ? 1u : 0u; mine = (j == x) ? c : mine; }
        if (sum == G) break;
        __builtin_amdgcn_s_sleep(1);
        if ((++sp & 255u) == 0u) { if (xb_ld(&bar[XB_TMO])) break; if (sp > XB_SPIN_CAP) { atomicAdd(&bar[XB_TMO], 1u); break; } }
    }
    nloc = mine > 0u ? mine : 1u; nx = cnt > 0u ? cnt : 1u;
}
__device__ __forceinline__ void xcd_barrier(const XcdBarrier& b) {
    asm volatile("s_waitcnt vmcnt(0)" ::: "memory");
    __syncthreads();
    if (threadIdx.x == 0) {
        unsigned* bar = b.bar;
        __builtin_amdgcn_s_waitcnt(0);
        unsigned nloc = b.st[0], nx = b.st[1];
        if (nloc == 0u) { xcd_barrier_complete(bar, b.x, nloc, nx); b.st[0] = nloc; b.st[1] = nx; }
        const unsigned old = xb_add(&bar[XB_XSUB(b.x)], 1u);
        const unsigned gen = old / nloc;
        if (old + 1u == (gen + 1u) * nloc) {
            __builtin_amdgcn_fence(__ATOMIC_RELEASE, "agent");
            asm volatile("s_waitcnt vmcnt(0)" ::: "memory");
            const unsigned og = xb_add(&bar[XB_TOP], 1u);
            const unsigned tg = og / nx;
            if (og + 1u == (tg + 1u) * nx) xb_add(&bar[XB_TOPGEN], 1u);
            else XB_SPIN(xb_ld(&bar[XB_TOPGEN]) == tg, bar);
            __builtin_amdgcn_fence(__ATOMIC_ACQUIRE, "agent");
            xb_add(&bar[XB_XGEN(b.x)], 1u);
            asm volatile("s_waitcnt vmcnt(0)" ::: "memory");
        } else {
            XB_SPIN(xb_ld(&bar[XB_XGEN(b.x)]) == gen, bar);
            __builtin_amdgcn_fence(__ATOMIC_ACQUIRE, "agent");
            asm volatile("s_waitcnt vmcnt(0)" ::: "memory");
        }
    }
    __syncthreads();
}

namespace pg8 {
constexpr int BM = 256, BK = 64, HALF = 128, HTB = HALF * BK * 2, STAGE_BYTES = 8 * HTB, NXCD = 8, WGM = 8;
constexpr int KDIM = 2048;
__host__ __device__ __forceinline__ int lds_byte(int r, int c) { const int st = (r >> 4) * 2 + (c >> 5), rr = r & 15, cc = c & 31, ob = rr * 64 + cc * 2; return st * 1024 + (ob ^ (((ob >> 9) & 1) << 5)); }
__host__ __device__ __forceinline__ void stage_rc(int b, int& R, int& C) { const int st = b / 1024, sb = b % 1024, swz = sb ^ (((sb >> 9) & 1) << 5); R = (st >> 1) * 16 + swz / 64; C = (st & 1) * 32 + (swz % 64) / 2; }
__host__ __device__ __forceinline__ int perm32(int rho) { const int n = rho >> 4, i = rho & 15; return 8 * (i >> 2) + 4 * n + (i & 3); }

struct Unit { int pm, pn, e, vr; const char* a; const char* b; };

struct DenseOrder {
    static constexpr bool GATHER = false;
    int nM, nN, nwg, G, c, first = 0, count = 1 << 30; const char* A; const char* Bt;
    __device__ __forceinline__ void prefetch(int) const {}
    __device__ void init(const bf16* A_, const bf16* Bt_, int M, int N, int G_, int c_) { nM = M / BM; nN = N / BM; nwg = nM * nN; G = G_; c = c_; A = (const char*)A_; Bt = (const char*)Bt_; }
    __device__ __forceinline__ bool next(int i, Unit& u) const {
        if (i >= count) return false; i += first;
        const long L = (long)i * G + c; if (L >= nwg) return false;
        int wgid = (int)L; { const int q = nwg / NXCD, r = nwg % NXCD, xcd = wgid % NXCD, off = wgid / NXCD; wgid = (xcd < r ? xcd * (q + 1) : r * (q + 1) + (xcd - r) * q) + off; }
        const int nig = WGM * nN, gid = wgid / nig, fm = gid * WGM, gsz = (nM - fm) < WGM ? (nM - fm) : WGM;
        u.pm = fm + ((wgid % nig) % gsz); u.pn = (wgid % nig) / gsz; u.e = 0; u.vr = BM;
        u.a = A + (size_t)u.pm * (size_t)(BM * KDIM * 2); u.b = Bt + (size_t)u.pn * (size_t)(BM * KDIM * 2); return true;
    }
};
template <bool GATH> struct MoeOrder {
    static constexpr bool GATHER = GATH;
    int nM, nN, nwg, lo, sz, mlo, base = 0, cap = 1 << 30;
    mutable int ndone = 0;
    const char* A; const char* Bt; const LAS int* te; const LAS int* tpx; const LAS unsigned* cnx; LAS int* tick; unsigned* qctr; size_t estride;
    __device__ void init(const bf16* A_, const bf16* Bt_, int ntiles, int NE, LAS unsigned char* lds, unsigned* qctr_, int q8) {
        nM = ntiles; nN = NE / BM; nwg = nM * nN; A = (const char*)A_; Bt = (const char*)Bt_; estride = (size_t)NE * KDIM * 2;
        te = (const LAS int*)(lds + TE_OFF); tpx = (const LAS int*)(lds + MISC_OFF + 1024); cnx = (const LAS unsigned*)(lds + CNT_OFF); tick = (LAS int*)(lds + TICK_OFF); qctr = qctr_;
        const int q = nwg / NXCD, r = nwg % NXCD; lo = q8 < r ? q8 * (q + 1) : r * (q + 1) + (q8 - r) * q; sz = q8 < r ? q + 1 : q;
        mlo = WGM * (lo / (WGM * nN)); }
    __device__ __forceinline__ void decode(int wgid, Unit& u) const {
        const int nig = WGM * nN, gid = wgid / nig, fm = gid * WGM, gsz = (nM - fm) < WGM ? (nM - fm) : WGM;
        u.pm = fm + ((wgid % nig) % gsz); u.pn = (wgid % nig) / gsz;
        u.e = __builtin_amdgcn_readfirstlane(te[u.pm]);
        { const int left = (int)cnx[u.e] - (u.pm - tpx[u.e]) * BM; u.vr = __builtin_amdgcn_readfirstlane(left < BM ? left : BM); }
        u.a = A + (size_t)u.pm * (size_t)(BM * KDIM * 2); u.b = Bt + (size_t)u.e * estride + (size_t)u.pn * (size_t)(BM * KDIM * 2); }
    __device__ __forceinline__ void prefetch(int i) const { if (threadIdx.x == 0) tick[(base + i) & 3] = (int)__hip_atomic_fetch_add(qctr, 1u, __ATOMIC_RELAXED, __HIP_MEMORY_SCOPE_AGENT); }
    __device__ __forceinline__ bool next(int i, Unit& u) const {
        if (i >= cap) return false;
        const int t = __builtin_amdgcn_readfirstlane(tick[(base + i) & 3]); if (t >= sz) return false;
        ndone = i + 1 > ndone ? i + 1 : ndone;
        decode(lo + t, u); return true; }
};

__device__ __forceinline__ unsigned cvt_pk_bf16(float lo, float hi) { return cvt2bf(lo, hi); }

template <class Epi, class Sched>
__device__ __forceinline__ void gemm_phase(LAS unsigned char* lds, const Sched& S, const Epi& E) {
    const int tid = threadIdx.x, wid = __builtin_amdgcn_readfirstlane(tid >> 6), lane = tid & 63, wr = wid >> 2, wc = wid & 3, fr = lane & 15, fq = lane >> 4;
    constexpr int K = KDIM, nt = K / BK;
    unsigned voffA[2], voffB[2];
#pragma unroll
    for (int i = 0; i < 2; ++i) { int R, C; stage_rc(tid * 16 + i * 8192, R, C); const int Rb = Epi::PERM ? ((R & ~31) + perm32(R & 31)) : R;
        voffA[i] = (unsigned)(R * K + C) * 2u; voffB[i] = (unsigned)(Rb * K + C) * 2u; }
    const size_t kstep = (size_t)(BK * 2);
    const size_t hstep = (size_t)HALF * K * 2;
    const unsigned ldsw = (unsigned)wid * 1024u;
    const int aoff = lds_byte(wr * 64 + fr, fq * 8), boff = lds_byte(wc * 32 + fr, fq * 8);
    unsigned vg[2][2] = {{0u, 0u}, {0u, 0u}}, nvg[2][2] = {{0u, 0u}, {0u, 0u}};
    const LAS unsigned short* gidx = (const LAS unsigned short*)(lds + IDX_OFF);
#define PG8_GIDX(dst, u_) do { int mt_ = 0; if constexpr (Sched::GATHER) mt_ = (u_).pm - S.mlo; mt_ = mt_ < 0 ? 0 : (mt_ < IDX_TILES ? mt_ : IDX_TILES - 1); \
    _Pragma("unroll") for (int _i = 0; _i < 2; ++_i) { int R_, C_; stage_rc(tid * 16 + _i * 8192, R_, C_); _Pragma("unroll") for (int _h = 0; _h < 2; ++_h) \
        dst[_h][_i] = (unsigned)gidx[mt_ * 256 + _h * HALF + R_] * (unsigned)(K * 2) + (unsigned)C_ * 2u; } } while (0)
#define PG8_SA(b, h) (((b) * 2 + (h)) * HTB)
#define PG8_SB(b, h) ((4 + (b) * 2 + (h)) * HTB)
#define PG8_STAGE_R(bufoff, gbase, voff, RS, BASE) do { const int so_ = (int)(unsigned)((const char*)(gbase) - (BASE)); _Pragma("unroll") for (int _i = 0; _i < 2; ++_i) \
        __builtin_amdgcn_raw_ptr_buffer_load_lds(RS, (LAS void*)(lds + (bufoff) + ldsw + _i * 8192), 16, (int)(voff)[_i], so_, 0, 0); } while (0)
#define PG8_STAGE(bufoff, gbase, voff) PG8_STAGE_R(bufoff, gbase, voff, rsB, S.Bt)
#define PG8_STAGE_A(bufoff, kofs, h, nx) do { if constexpr (Sched::GATHER) { const int so_ = (int)(unsigned)(kofs); \
        _Pragma("unroll") for (int _i = 0; _i < 2; ++_i) { const unsigned vo_ = (nx) ? nvg[h][_i] : vg[h][_i]; \
            __builtin_amdgcn_raw_ptr_buffer_load_lds(rsA, (LAS void*)(lds + (bufoff) + ldsw + _i * 8192), 16, (int)vo_, so_, 0, 0); } } \
    else { PG8_STAGE_R(bufoff, ((nx) ? nA : cA) + (size_t)(kofs) + (size_t)(h) * hstep, voffA, rsA, S.A); } } while (0)
#define PG8_LDA(dst, b, h) do { _Pragma("unroll") for (int m = 0; m < 4; ++m) _Pragma("unroll") for (int k = 0; k < 2; ++k) dst[m][k] = *(const LAS bf16x8*)(lds + PG8_SA(b, h) + aoff + m * 2048 + k * 1024); } while (0)
#define PG8_LDB(dst, b, h) do { _Pragma("unroll") for (int n = 0; n < 2; ++n) _Pragma("unroll") for (int k = 0; k < 2; ++k) dst[n][k] = *(const LAS bf16x8*)(lds + PG8_SB(b, h) + boff + n * 2048 + k * 1024); } while (0)
#define PG8_MMA1(ai, bj, At, Bt) do { _Pragma("unroll") for (int m = 0; m < 4; ++m) _Pragma("unroll") for (int n = 0; n < 2; ++n) _Pragma("unroll") for (int k = 0; k < 2; ++k) \
        acc[ai][bj][m][n] = __builtin_amdgcn_mfma_f32_16x16x32_bf16(Bt[n][k], At[m][k], acc[ai][bj][m][n], 0, 0, 0); } while (0)
#define PG8_MMA2(ai, At) do { __builtin_amdgcn_s_setprio(1); PG8_MMA1(ai, 0, At, B0); PG8_MMA1(ai, 1, At, B1); __builtin_amdgcn_s_setprio(0); } while (0)
#define PG8_WAIT_V(n) asm volatile("s_waitcnt vmcnt(" #n ")" ::: "memory")
#define PG8_WAIT_L(n) asm volatile("s_waitcnt lgkmcnt(" #n ")" ::: "memory")
#define PG8_BAR __builtin_amdgcn_s_barrier()
#define PG8_SCHED __builtin_amdgcn_sched_barrier(0)
    Unit cur, nxt; int ui = 0;
    if (!S.next(0, cur)) return;
    LAS float* bxw = (LAS float*)(lds + MISC_OFF + 2048) + wid * 64;
    float b1 = E.pre(cur, wc, lane);
    const __amdgpu_buffer_rsrc_t rsA = __builtin_amdgcn_make_buffer_rsrc((void*)S.A, 0, 0x7fffffff, 0x00020000), rsB = __builtin_amdgcn_make_buffer_rsrc((void*)S.Bt, 0, 0x7fffffff, 0x00020000);
    f32x4 acc[2][2][4][2];
#pragma unroll
    for (int a = 0; a < 2; ++a)
#pragma unroll
        for (int b = 0; b < 2; ++b)
#pragma unroll
            for (int m = 0; m < 4; ++m)
#pragma unroll
                for (int n = 0; n < 2; ++n) acc[a][b][m][n] = (f32x4){0.f, 0.f, 0.f, 0.f};
    bf16x8 At[4][2], B0[2][2], B1[2][2];
    const char* cA = cur.a; const char* cB = cur.b;
    const char* nA = cA;
    if constexpr (Sched::GATHER) { PG8_GIDX(vg, cur); }
    PG8_STAGE(PG8_SB(0, 0), cB, voffB); PG8_STAGE(PG8_SB(0, 1), cB + hstep, voffB); PG8_STAGE_A(PG8_SA(0, 0), 0, 0, false); PG8_STAGE_A(PG8_SA(0, 1), 0, 1, false);
    if (wr == 1) PG8_BAR;
    PG8_WAIT_V(2); PG8_BAR;
    PG8_STAGE(PG8_SB(1, 0), cB + kstep, voffB); PG8_STAGE_A(PG8_SA(1, 0), kstep, 0, false); PG8_STAGE(PG8_SB(1, 1), cB + hstep + kstep, voffB);
    PG8_WAIT_V(6); PG8_BAR;
    for (;;) {
        const bool has_next = S.next(ui + 1, nxt);
        S.prefetch(ui + 2);
        nA = has_next ? nxt.a : cA; const char* nB = has_next ? nxt.b : cB;
#define PG8_KLOOP(LIVE1) do { \
        for (int t = 0; t < nt; t += 2) { \
            const bool last = (t == nt - 2); \
            if constexpr (Sched::GATHER) { if (last) { if (has_next) { PG8_GIDX(nvg, nxt); } else { PG8_GIDX(nvg, cur); } } } \
            const size_t k1 = (size_t)(t + 1) * kstep, k2 = last ? (size_t)0 : (size_t)(t + 2) * kstep, k3 = k2 + kstep; \
            const char* b2 = last ? nB : cB + (size_t)(t + 2) * kstep; const char* b3 = b2 + kstep; \
            PG8_LDB(B0, 0, 0); PG8_LDB(B1, 0, 1); PG8_SCHED; PG8_LDA(At, 0, 0); PG8_STAGE_A(PG8_SA(1, 1), k1, 1, false); \
            PG8_WAIT_V(8); PG8_WAIT_L(0); PG8_BAR; PG8_MMA2(0, At); PG8_BAR; PG8_SCHED; \
            if (LIVE1) { PG8_LDA(At, 0, 1); } PG8_STAGE(PG8_SB(0, 0), b2, voffB); PG8_STAGE(PG8_SB(0, 1), b2 + hstep, voffB); PG8_STAGE_A(PG8_SA(0, 0), k2, 0, last); \
            PG8_WAIT_V(8); PG8_WAIT_L(0); PG8_BAR; if (LIVE1) { PG8_MMA2(1, At); } PG8_BAR; PG8_SCHED; \
            PG8_LDB(B0, 1, 0); PG8_LDB(B1, 1, 1); PG8_SCHED; PG8_LDA(At, 1, 0); PG8_STAGE_A(PG8_SA(0, 1), k2, 1, last); \
            PG8_WAIT_V(8); PG8_WAIT_L(0); PG8_BAR; PG8_MMA2(0, At); PG8_BAR; PG8_SCHED; \
            if (LIVE1) { PG8_LDA(At, 1, 1); } PG8_STAGE(PG8_SB(1, 0), b3, voffB); PG8_STAGE(PG8_SB(1, 1), b3 + hstep, voffB); PG8_STAGE_A(PG8_SA(1, 0), k3, 0, last); \
            PG8_WAIT_V(8); PG8_WAIT_L(0); PG8_BAR; if (LIVE1) { PG8_MMA2(1, At); } PG8_BAR; PG8_SCHED; \
        } } while (0)
        if (cur.vr > HALF) PG8_KLOOP(true); else PG8_KLOOP(false);
        if constexpr (Epi::ALIGN) { if (wr == 0) PG8_BAR; }
        E(acc, cur, wr, wc, fr, fq, b1, bxw);
        if (!has_next) break;
#pragma unroll
        for (int a = 0; a < 2; ++a)
#pragma unroll
            for (int b = 0; b < 2; ++b)
#pragma unroll
                for (int m = 0; m < 4; ++m)
#pragma unroll
                    for (int n = 0; n < 2; ++n) acc[a][b][m][n] = (f32x4){0.f, 0.f, 0.f, 0.f};
        cur = nxt; cA = nA; cB = nB; ++ui;
        b1 = E.pre(cur, wc, lane);
        if constexpr (Sched::GATHER) { PG8_GIDX(vg, cur); }
        if constexpr (Epi::ALIGN) { if (wr == 1) PG8_BAR; }
    }
    if constexpr (!Epi::ALIGN) { if (wr == 0) PG8_BAR; }
    PG8_WAIT_V(0);
    PG8_BAR;
#undef PG8_SA
#undef PG8_SB
#undef PG8_STAGE
#undef PG8_STAGE_R
#undef PG8_STAGE_A
#undef PG8_KLOOP
#undef PG8_GIDX
#undef PG8_LDA
#undef PG8_LDB
#undef PG8_MMA1
#undef PG8_MMA2
#undef PG8_WAIT_V
#undef PG8_WAIT_L
#undef PG8_BAR
#undef PG8_SCHED
}

constexpr float DA_QSCALE = 0.125f * 1.4426950408889634f;
struct EpiProj {
    static constexpr bool PERM = true, ALIGN = true;
    __device__ __forceinline__ float pre(const Unit&, int, int) const { return 0.f; }
    bf16 *sbq, *sbk, *sbv, *daq, *dak, *dav; const float* rope;
    __device__ __forceinline__ void operator()(const f32x4 (&acc)[2][2][4][2], const Unit& u, int wr, int wc, int fr, int fq, float b1, LAS float* bx) const {
        const int ty = u.pn >> 2;
        bf16* base = ty == 0 ? sbq : ty == 1 ? sbk : ty == 2 ? sbv : ty == 3 ? daq : ty == 4 ? dak : dav;
        const bool kv = (ty != 0 && ty != 3);
        const int bb = u.pm >> 4;
        const int rowadd = kv ? 64 * (bb + 1) : 0;
        const int row0 = u.pm * BM + wr * 64 + fr, col0 = (u.pn & 3) * BM + wc * 32 + 8 * fq;
        const bool rope_wave = (ty == 3 || ty == 4) && ((wc & 1) == 0);
        f32x4 rp4[8][4];
#define ROPE_LD(st) do { if (rope_wave) { const int r_ = row0 + ((st) >> 2) * HALF + ((st) & 3) * 16; const float* rp = rope + (size_t)(NMETA + (r_ & (SEQ - 1))) * 16; \
            rp4[st][0] = *(const f32x4*)(rp); rp4[st][1] = *(const f32x4*)(rp + 4); rp4[st][2] = *(const f32x4*)(rp + 8); rp4[st][3] = *(const f32x4*)(rp + 12); } } while (0)
        ROPE_LD(0); ROPE_LD(1);
#pragma unroll
        for (int st = 0; st < 8; ++st) { const int ai = st >> 2, m = st & 3;
                const int r = row0 + ai * HALF + m * 16;
                bf16* rowp = base + (size_t)(r + rowadd) * HW + col0;
                if (st + 2 < 8) ROPE_LD(st + 2);
#pragma unroll
                for (int bj = 0; bj < 2; ++bj) {
                    f32x4 v0 = acc[ai][bj][m][0], v1 = acc[ai][bj][m][1];
                    if (rope_wave) {
                        const f32x4 cs0 = rp4[st][0], cs1 = rp4[st][1], sn0 = rp4[st][2], sn1 = rp4[st][3];
                        f32x4 o0, o1;
#pragma unroll
                        for (int j = 0; j < 4; ++j) { o0[j] = __shfl_xor(v0[j], 16); o1[j] = __shfl_xor(v1[j], 16); }
                        if (fq == 0) { v0 = v0 * cs0 - o0 * sn0; v1 = v1 * cs1 - o1 * sn1; }
                        else if (fq == 1) { v0 = v0 * cs0 + o0 * sn0; v1 = v1 * cs1 + o1 * sn1; }
                    }
                    if (ty == 3) { v0 = v0 * DA_QSCALE; v1 = v1 * DA_QSCALE; }
                    v4u w; w.x = cvt_pk_bf16(v0[0], v0[1]); w.y = cvt_pk_bf16(v0[2], v0[3]); w.z = cvt_pk_bf16(v1[0], v1[1]); w.w = cvt_pk_bf16(v1[2], v1[3]);
                    *(v4u*)(rowp + bj * HALF) = w; } }
#undef ROPE_LD
    }
};
struct EpiRes {
    static constexpr bool PERM = true, ALIGN = false;
    __device__ __forceinline__ float pre(const Unit&, int, int) const { return 0.f; }
    const float* x; bf16* out;
    __device__ __forceinline__ void operator()(const f32x4 (&acc)[2][2][4][2], const Unit& u, int wr, int wc, int fr, int fq, float b1, LAS float* bx) const {
        const int row0 = u.pm * BM + wr * 64 + fr, col0 = u.pn * BM + wc * 32 + 8 * fq;
        f32x4 xs[8][4];
#define RES_LD(st) do { const size_t off_ = (size_t)(row0 + ((st) >> 2) * HALF + ((st) & 3) * 16) * DM + col0; \
            xs[st][0] = *(const f32x4*)(x + off_); xs[st][1] = *(const f32x4*)(x + off_ + 4); xs[st][2] = *(const f32x4*)(x + off_ + HALF); xs[st][3] = *(const f32x4*)(x + off_ + HALF + 4); } while (0)
        RES_LD(0); RES_LD(1); RES_LD(2); RES_LD(3);
#pragma unroll
        for (int st = 0; st < 8; ++st) { const int ai = st >> 2, m = st & 3; const size_t off = (size_t)(row0 + ai * HALF + m * 16) * DM + col0;
            if (st + 4 < 8) RES_LD(st + 4);
#pragma unroll
            for (int bj = 0; bj < 2; ++bj) { const f32x4 v0 = xs[st][2 * bj] + acc[ai][bj][m][0], v1 = xs[st][2 * bj + 1] + acc[ai][bj][m][1];
                v4u w; w.x = cvt_pk_bf16(v0[0], v0[1]); w.y = cvt_pk_bf16(v0[2], v0[3]); w.z = cvt_pk_bf16(v1[0], v1[1]); w.w = cvt_pk_bf16(v1[2], v1[3]);
                *(v4u*)(out + off + bj * HALF) = w; } }
#undef RES_LD
    }
};
struct EpiSwiglu {
    static constexpr bool PERM = true, ALIGN = false;
    __device__ __forceinline__ float pre(const Unit& u, int wc, int lane) const { return bgu[(size_t)u.e * 4096 + u.pn * HALF + wc * 32 + (lane & 31) + (lane >> 5) * 2048]; }
    bf16* act; const float* bgu;
    __device__ __forceinline__ void operator()(const f32x4 (&acc)[2][2][4][2], const Unit& u, int wr, int wc, int fr, int fq, float b1, LAS float* bx) const {
        const int row0 = u.pm * BM + wr * 64 + fr, col0 = u.pn * HALF + wc * 32 + 8 * fq;
        bx[threadIdx.x & 63] = b1;
        const f32x4 g0 = *(const LAS f32x4*)(bx + 8 * fq), g1 = *(const LAS f32x4*)(bx + 8 * fq + 4), u0 = *(const LAS f32x4*)(bx + 32 + 8 * fq), u1 = *(const LAS f32x4*)(bx + 36 + 8 * fq);
#pragma unroll
        for (int ai = 0; ai < 2; ++ai)
#pragma unroll
            for (int m = 0; m < 4; ++m) {
                bf16* rowp = act + (size_t)(row0 + ai * HALF + m * 16) * DM + col0;
                float o[8];
#pragma unroll
                for (int n = 0; n < 2; ++n)
#pragma unroll
                    for (int j = 0; j < 4; j += 2) {
                        const f32x4 gb = n ? g1 : g0, ub = n ? u1 : u0;
                        const f32x2_t hg = f32x2_t{acc[ai][0][m][n][j], acc[ai][0][m][n][j + 1]} + f32x2_t{gb[j], gb[j + 1]};
                        const f32x2_t hu = f32x2_t{acc[ai][1][m][n][j], acc[ai][1][m][n][j + 1]} + f32x2_t{ub[j], ub[j + 1]};
                        const f32x2_t gt = {fminf(hg[0], 7.0f), fminf(hg[1], 7.0f)}, up = {fminf(fmaxf(hu[0], -7.0f), 7.0f), fminf(fmaxf(hu[1], -7.0f), 7.0f)};
                        const f32x2_t t = gt * (-1.702f * 1.4426950408889634f);
                        const f32x2_t dn = f32x2_t{__builtin_amdgcn_exp2f(t[0]), __builtin_amdgcn_exp2f(t[1])} + 1.0f;
                        const f32x2_t sg = {__builtin_amdgcn_rcpf(dn[0]), __builtin_amdgcn_rcpf(dn[1])};
                        const f32x2_t r2 = (up * gt + gt) * sg;
                        o[n * 4 + j] = r2[0]; o[n * 4 + j + 1] = r2[1]; }
                v4u w; w.x = cvt_pk_bf16(o[0], o[1]); w.y = cvt_pk_bf16(o[2], o[3]); w.z = cvt_pk_bf16(o[4], o[5]); w.w = cvt_pk_bf16(o[6], o[7]);
                *(v4u*)rowp = w; }
    }
};
struct EpiDown {
    static constexpr bool PERM = true, ALIGN = true;
    __device__ __forceinline__ float pre(const Unit& u, int wc, int lane) const { return bdn[(size_t)u.e * DM + u.pn * BM + wc * 32 + (lane & 31) + (lane >> 5) * HALF]; }
    bf16* ys; const float* bdn;
    __device__ __forceinline__ void operator()(const f32x4 (&acc)[2][2][4][2], const Unit& u, int wr, int wc, int fr, int fq, float b1, LAS float* bx) const {
        const int row0 = u.pm * BM + wr * 64 + fr, col0 = u.pn * BM + wc * 32 + 8 * fq;
        bx[threadIdx.x & 63] = b1;
        f32x4 bv[2][2];
#pragma unroll
        for (int bj = 0; bj < 2; ++bj)
#pragma unroll
            for (int n = 0; n < 2; ++n) bv[bj][n] = *(const LAS f32x4*)(bx + bj * 32 + 8 * fq + 4 * n);
#pragma unroll
        for (int ai = 0; ai < 2; ++ai)
#pragma unroll
            for (int m = 0; m < 4; ++m) { bf16* rowp = ys + (size_t)(row0 + ai * HALF + m * 16) * DM + col0;
#pragma unroll
                for (int bj = 0; bj < 2; ++bj) { const f32x4 v0 = acc[ai][bj][m][0] + bv[bj][0], v1 = acc[ai][bj][m][1] + bv[bj][1];
                    v4u w; w.x = cvt_pk_bf16(v0[0], v0[1]); w.y = cvt_pk_bf16(v0[2], v0[3]); w.z = cvt_pk_bf16(v1[0], v1[1]); w.w = cvt_pk_bf16(v1[2], v1[3]);
                    *(v4u*)(rowp + bj * HALF) = w; } }
    }
};
}

struct Args { const float* in[19]; float* out; unsigned char* ws; int ph_lo, ph_hi; };
enum { I_X = 0, I_META, I_GMIX, I_WIN, I_LQ1, I_LK1, I_LQ2, I_LK2, I_GSB, I_GDA, I_WOUT, I_GFFN, I_WR, I_BR, I_WGU, I_BGU, I_WDN, I_BDN, I_GFIN };
constexpr int NWAVES = 8;

struct TrItem { const float* src; bf16* dst; int N; };
__device__ __forceinline__ TrItem tr_decode(const Args& a, int it) {
    unsigned char* ws = a.ws;
    constexpr int T_IN = 32 * (INCOLS / 64), T_OUT = 32 * (DM / 64), T_GU1 = 32 * (4096 / 64), T_DN1 = 32 * (DM / 64);
    TrItem t; int r = it;
    if (r < T_IN) { const int kb = r & 31, nb = r >> 5; t.N = INCOLS; t.src = a.in[I_WIN] + (size_t)(64 * kb) * INCOLS + 64 * nb; t.dst = (bf16*)(ws + WS_WIN) + (size_t)(64 * nb) * DM + 64 * kb; return t; } r -= T_IN;
    if (r < T_OUT) { const int kb = r & 31, nb = r >> 5; t.N = DM; t.src = a.in[I_WOUT] + (size_t)(64 * kb) * DM + 64 * nb; t.dst = (bf16*)(ws + WS_WOUT) + (size_t)(64 * nb) * DM + 64 * kb; return t; } r -= T_OUT;
    if (r < NEXP * T_GU1) { const int e = r / T_GU1, q = r % T_GU1, kb = q & 31, nb = q >> 5, n0 = 64 * nb;
        const int drow0 = n0 < 2048 ? (n0 >> 7) * 256 + (n0 & 127) : ((n0 - 2048) >> 7) * 256 + 128 + ((n0 - 2048) & 127);
        t.N = 4096; t.src = a.in[I_WGU] + (size_t)e * DM * 4096 + (size_t)(64 * kb) * 4096 + n0; t.dst = (bf16*)(ws + WS_WGU) + (size_t)e * 4096 * DM + (size_t)drow0 * DM + 64 * kb; return t; } r -= NEXP * T_GU1;
    { const int e = r / T_DN1, q = r % T_DN1, kb = q & 31, nb = q >> 5;
        t.N = DM; t.src = a.in[I_WDN] + (size_t)e * DM * DM + (size_t)(64 * kb) * DM + 64 * nb; t.dst = (bf16*)(ws + WS_WDN) + (size_t)e * DM * DM + (size_t)(64 * nb) * DM + 64 * kb; return t; }
}
constexpr int TR_NITEMS = 32 * (INCOLS / 64) + 32 * (DM / 64) + NEXP * 32 * (4096 / 64) + NEXP * 32 * (DM / 64);
__device__ __forceinline__ void tr_load(const TrItem& t, f32x4 (&ra)[8], f32x4 (&rb)[8], int lane) {
    const int q = lane >> 4, n4 = lane & 15;
    const float* p = t.src + (size_t)(2 * q) * t.N + 4 * n4;
#pragma unroll
    for (int i = 0; i < 8; ++i) { ra[i] = __builtin_nontemporal_load((const f32x4*)(p + (size_t)(8 * i) * t.N)); rb[i] = __builtin_nontemporal_load((const f32x4*)(p + (size_t)(8 * i + 1) * t.N)); }
}
__device__ __forceinline__ void tr_store(const TrItem& t, const f32x4 (&ra)[8], const f32x4 (&rb)[8], LAS unsigned* scr, int lane) {
    const int q = lane >> 4, n4 = lane & 15;
#pragma unroll
    for (int i = 0; i < 8; ++i)
#pragma unroll
        for (int j = 0; j < 4; ++j) scr[(4 * n4 + j) * 32 + ((i ^ (n4 & 7)) << 2) + q] = cvt2bf(ra[i][j], rb[i][j]);
    LDS_WAIT(); asm volatile("" ::: "memory");
    const int nr = lane >> 3, ch = lane & 7;
#pragma unroll
    for (int i = 0; i < 8; ++i) { const int n = nr + 8 * i; const v4u v = *(const LAS v4u*)(scr + n * 32 + ((ch ^ ((n >> 2) & 7)) << 2));
        __builtin_nontemporal_store(v, (v4u*)(t.dst + (size_t)n * DM + 8 * ch)); }
    LDS_WAIT(); asm volatile("" ::: "memory");
}
constexpr int TR_SMALL = 32 * (INCOLS / 64) + 32 * (DM / 64);
__device__ __forceinline__ void conv_items(const Args& a, LAS unsigned char* lds, int it0, int it1, int vcu, int G, int lane, int wave) {
    LAS unsigned* scr = (LAS unsigned*)(lds + wave * 16384);
    const int gw = vcu * NWAVES + wave, NGW = G * NWAVES;
    f32x4 ra[8], rb[8], na[8], nb_[8];
    int it = it0 + gw;
    if (it >= it1) return;
    TrItem cur = tr_decode(a, it);
    tr_load(cur, ra, rb, lane);
    for (;;) {
        int nx = it + NGW; bool has = nx < it1;
        TrItem nxt = tr_decode(a, has ? nx : it);
        if (has) tr_load(nxt, na, nb_, lane);
        tr_store(cur, ra, rb, scr, lane);
        if (!has) break;
        it = nx; nx = it + NGW; has = nx < it1;
        cur = tr_decode(a, has ? nx : it);
        if (has) tr_load(cur, ra, rb, lane);
        tr_store(nxt, na, nb_, scr, lane);
        if (!has) break;
        it = nx;
    }
}
constexpr int TR_GU_END = TR_SMALL + NEXP * 32 * (4096 / 64);
constexpr int TR_S1 = TR_SMALL + (TR_GU_END - TR_SMALL) * 45 / 100, TR_S2 = TR_SMALL + (TR_GU_END - TR_SMALL) * 85 / 100;
__device__ __forceinline__ void conv_slice(const Args& a, LAS unsigned char* lds, int which, int vcu, int G, int lane, int wave) {
    const int it0 = which == 0 ? TR_SMALL : which == 1 ? TR_S1 : which == 2 ? TR_S2 : TR_GU_END, it1 = which == 0 ? TR_S1 : which == 1 ? TR_S2 : which == 2 ? TR_GU_END : TR_NITEMS;
    conv_items(a, lds, it0, it1, vcu, G, lane, wave);
    __syncthreads();
}
__device__ __forceinline__ void rms_row_to_bf16(const float* xrow, const float* g, bf16* orow, int lane) {
    const f32x4* xr = (const f32x4*)xrow + lane; const f32x4* gr = (const f32x4*)g + lane;
    f32x4 v[8]; float s = 0.f;
#pragma unroll
    for (int j = 0; j < 8; ++j) { v[j] = xr[64 * j]; s += (v[j].x * v[j].x + v[j].y * v[j].y) + (v[j].z * v[j].z + v[j].w * v[j].w); }
    const float rstd = 1.0f / sqrtf(wave_sum(s) * (1.f / DM) + RMS_EPS);
    v2u* o8 = (v2u*)orow + lane;
#pragma unroll
    for (int j = 0; j < 8; ++j) { const f32x4 gg = gr[64 * j]; v2u w; w.x = pk2(v[j].x * rstd * gg.x, v[j].y * rstd * gg.y); w.y = pk2(v[j].z * rstd * gg.z, v[j].w * rstd * gg.w); o8[64 * j] = w; }
}
__device__ __forceinline__ void sincos_rev(double t, float& s, float& c) {
    t -= __builtin_rint(t);
    const double x = t * 6.283185307179586476925286766559, x2 = x * x;
    double ts = x, ss = x, tc = 1.0, cc = 1.0;
#pragma unroll
    for (int k = 1; k <= 14; ++k) { ts *= -x2 / (double)((2 * k) * (2 * k + 1)); ss += ts; tc *= -x2 / (double)((2 * k - 1) * (2 * k)); cc += tc; }
    s = (float)ss; c = (float)cc;
}

__device__ __forceinline__ float rope_inv_freq(int j) {
    return j == 0 ? 1.0f : j == 1 ? 0.1939227432012558f : j == 2 ? 0.03760603070259094f : j == 3 ? 0.007292664609849453f : j == 4 ? 0.0014142135623842478f : j == 5 ? 0.00027424818836152554f : j == 6 ? 5.318296098266728e-05f : 1.0313386155758053e-05f;
}
__device__ __forceinline__ void phase0(const Args& a, LAS unsigned char* lds, int vcu, int G, int tid, int lane, int wave) {
    unsigned char* ws = a.ws;
    for (int unit = vcu; unit < 256; unit += G) {
        LAS float* um = (LAS float*)lds;
        for (int rr = 0; rr < 2; ++rr) { const int r = wave * 2 + rr;
            const f32x4* xr = (const f32x4*)(a.in[I_META] + (size_t)r * DM) + lane; const f32x4* gr = (const f32x4*)a.in[I_GMIX] + lane;
            f32x4 v[8]; float s = 0.f;
#pragma unroll
            for (int j = 0; j < 8; ++j) { v[j] = xr[64 * j]; s += (v[j].x * v[j].x + v[j].y * v[j].y) + (v[j].z * v[j].z + v[j].w * v[j].w); }
            const float rstd = 1.0f / sqrtf(wave_sum(s) * (1.f / DM) + RMS_EPS);
#pragma unroll
            for (int j = 0; j < 8; ++j) { const f32x4 gg = gr[64 * j]; *(LAS f32x4*)(um + r * DM + 4 * (lane + 64 * j)) = v[j] * rstd * gg; } }
        __syncthreads();
        const int grp = unit >> 6, cbase = (unit & 63) * 16;
        const int cl = tid & 15, ks = tid >> 4;
        const int scol = (grp == 0 ? 1024 : grp == 1 ? 2048 : grp == 2 ? 4096 : 5120) + cbase + cl;
        float acc[16];
#pragma unroll
        for (int r = 0; r < 16; ++r) acc[r] = 0.f;
        const float* wp = a.in[I_WIN] + (size_t)(ks * 64) * INCOLS + scol;
#pragma unroll 1
        for (int kb = 0; kb < 8; ++kb) { float w[8];
#pragma unroll
            for (int q = 0; q < 8; ++q) w[q] = wp[(size_t)(kb * 8 + q) * INCOLS];
#pragma unroll
            for (int q4 = 0; q4 < 2; ++q4)
#pragma unroll
                for (int r = 0; r < 16; ++r) { const f32x4 u = *(const LAS f32x4*)(um + r * DM + ks * 64 + kb * 8 + 4 * q4);
                    acc[r] += (u.x * w[4 * q4] + u.y * w[4 * q4 + 1]) + (u.z * w[4 * q4 + 2] + u.w * w[4 * q4 + 3]); } }
        __syncthreads();
        LAS float* red = (LAS float*)lds;
#pragma unroll
        for (int r = 0; r < 16; ++r) red[(ks * 16 + r) * 16 + cl] = acc[r];
        __syncthreads();
        LAS float* res = red + 32 * 16 * 16;
        if (tid < 256) { float sm = 0.f;
#pragma unroll
            for (int q = 0; q < 32; ++q) sm += red[(q * 16 + (tid >> 4)) * 16 + (tid & 15)];
            res[tid] = sm; }
        __syncthreads();
        bf16* dst = (bf16*)(ws + (grp == 0 ? WS_SBK : grp == 1 ? WS_SBV : grp == 2 ? WS_DAK : WS_DAV));
        if (tid < 256) { const int r = tid >> 4, c = tid & 15; float v = res[tid];
            if (grp == 2) { const int d = (cbase + c) & 63;
                if (d < 16) { float sn, cs; { const float ang = (float)r * rope_inv_freq(d & 7); sincos_rev((double)ang * 0.15915494309189533576888376337251, sn, cs); }
                    const float other = res[r * 16 + (c ^ 8)];
                    v = (d < 8) ? v * cs - other * sn : v * cs + other * sn; } }
            const unsigned short bv = (unsigned short)f2bf(v);
#pragma unroll
            for (int b = 0; b < BATCH; ++b) dst[(size_t)(b * LPB + KVPAD + r) * HW + cbase + c] = bv; }
        __syncthreads();
    }
    { const int gt = vcu * 512 + tid, NT = G * 512;
      for (int i = gt; i < 4 * BATCH * KVPAD * (HW / 8); i += NT) { const int t = i / (BATCH * KVPAD * (HW / 8)), rem = i % (BATCH * KVPAD * (HW / 8)), b = rem / (KVPAD * (HW / 8)), rr = (rem / (HW / 8)) % KVPAD, c8 = rem % (HW / 8);
          bf16* dst = (bf16*)(ws + (t == 0 ? WS_SBK : t == 1 ? WS_SBV : t == 2 ? WS_DAK : WS_DAV));
          *(v4u*)(dst + (size_t)(b * LPB + rr) * HW + c8 * 8) = (v4u){0u, 0u, 0u, 0u}; }
      float* rope = (float*)(ws + WS_ROPE);
      for (int i = gt; i < (NMETA + SEQ) * 8; i += NT) { const int pos = i >> 3, j = i & 7;
          const float ang = (float)pos * rope_inv_freq(j); float sn, cs; sincos_rev((double)ang * 0.15915494309189533576888376337251, sn, cs);
          rope[pos * 16 + j] = cs; rope[pos * 16 + 8 + j] = sn; }
      { float* wgt = (float*)(ws + WS_WG); for (int i = gt; i < DM * NEXP; i += NT) wgt[i] = a.in[I_GFFN][i >> 5] * a.in[I_WR][i]; }
      if (vcu == 0 && wave == 0) { const float d1 = wave_sum(a.in[I_LQ1][lane] * a.in[I_LK1][lane]), d2 = wave_sum(a.in[I_LQ2][lane] * a.in[I_LK2][lane]);
          if (lane == 0) ((float*)(ws + WS_CTL))[CW_LAM] = expf(d1) - expf(d2) + LAM_INIT; } }
    conv_items(a, lds, 0, TR_SMALL, vcu, G, lane, wave);
    { const int gw = vcu * NWAVES + wave, NGW = G * NWAVES;
      f32x4 gg[8], cur[8];
      { const f32x4* gr = (const f32x4*)a.in[I_GMIX] + lane;
#pragma unroll
        for (int j = 0; j < 8; ++j) gg[j] = gr[64 * j]; }
      { const f32x4* xr = (const f32x4*)(a.in[I_X] + (size_t)(gw < NTOK ? gw : NTOK - 1) * DM) + lane;
#pragma unroll
        for (int j = 0; j < 8; ++j) cur[j] = xr[64 * j]; }
      for (int m = gw; m < NTOK; m += NGW) {
          f32x4 nxt[8];
          { const int mn = m + NGW < NTOK ? m + NGW : NTOK - 1; const f32x4* xr = (const f32x4*)(a.in[I_X] + (size_t)mn * DM) + lane;
#pragma unroll
            for (int j = 0; j < 8; ++j) nxt[j] = xr[64 * j]; }
          float sq = 0.f;
#pragma unroll
          for (int j = 0; j < 8; ++j) sq += (cur[j].x * cur[j].x + cur[j].y * cur[j].y) + (cur[j].z * cur[j].z + cur[j].w * cur[j].w);
          const float rstd = __builtin_amdgcn_rsqf(wave_sum(sq) * (1.f / DM) + RMS_EPS);
          v2u* o8 = (v2u*)((bf16*)(ws + WS_U) + (size_t)m * DM) + lane;
#pragma unroll
          for (int j = 0; j < 8; ++j) { const f32x4 uu = cur[j] * rstd * gg[j]; v2u w; w.x = cvt2bf(uu.x, uu.y); w.y = cvt2bf(uu.z, uu.w); o8[64 * j] = w; }
#pragma unroll
          for (int j = 0; j < 8; ++j) cur[j] = nxt[j];
      }
    }
}

__device__ __forceinline__ void phase4(const Args& a, LAS unsigned char* lds, int vcu, int G, int tid, int lane, int wave) {
    unsigned char* ws = a.ws;
    LAS float* xs = (LAS float*)lds;
    LAS float* red = (LAS float*)(lds + 66048);
    LAS float* lg = (LAS float*)(lds + 99840);
    LAS float* rsd = (LAS float*)(lds + 104064);
    LAS unsigned* cl = (LAS unsigned*)(lds + 104192);
    LAS int* sel_e = (LAS int*)(lds + 104448); LAS int* sel_r = sel_e + 128; LAS float* sel_g = (LAS float*)(sel_r + 128);
    int* r_e = (int*)(ws + WS_ROUTE); float* r_g = (float*)(ws + WS_ROUTE + 256 * 1024); int* r_rank = (int*)(ws + WS_ROUTE + 512 * 1024);
    int* elist = (int*)(ws + WS_ELIST);
    unsigned* cnt = (unsigned*)(ws + WS_CTL) + CW_CNT;
    const float* wg = (const float*)(ws + WS_WG);
    const int r32 = lane & 31, hi = lane >> 5;
    f32x4 gff[8];
    { const f32x4* gr = (const f32x4*)a.in[I_GFFN] + lane;
#pragma unroll
      for (int j = 0; j < 8; ++j) gff[j] = gr[64 * j]; }
    for (int grp = vcu; grp < NTOK / 32; grp += G) {
        const int tok0 = grp * 32;
        f32x4 v[4][8]; float rs4[4];
#pragma unroll
        for (int rr = 0; rr < 4; ++rr) { const int m = tok0 + 4 * wave + rr;
            const v2u* xr = (const v2u*)((const bf16*)(ws + WS_U) + (size_t)m * DM) + lane;
            float s = 0.f;
#pragma unroll
            for (int j = 0; j < 8; ++j) { const v2u hw = xr[64 * j]; v[rr][j] = (f32x4){bflo(hw.x), bfhi(hw.x), bflo(hw.y), bfhi(hw.y)}; s += (v[rr][j].x * v[rr][j].x + v[rr][j].y * v[rr][j].y) + (v[rr][j].z * v[rr][j].z + v[rr][j].w * v[rr][j].w); }
            rs4[rr] = 1.0f / sqrtf(wave_sum(s) * (1.f / DM) + RMS_EPS); }
#pragma unroll
        for (int rr = 0; rr < 4; ++rr) { const int m = tok0 + 4 * wave + rr; const float rstd = rs4[rr];
            v2u* o8 = (v2u*)((bf16*)(ws + WS_U2) + (size_t)m * DM) + lane;
#pragma unroll
            for (int j = 0; j < 8; ++j) { const f32x4 uu = v[rr][j] * rstd * gff[j]; v2u w; w.x = cvt2bf(uu.x, uu.y); w.y = cvt2bf(uu.z, uu.w); o8[64 * j] = w; }
            if (lane == 0) rsd[4 * wave + rr] = rstd; }
        if (tid < 32) cl[tid] = 0u;
        f32x16 acc;
#pragma unroll
        for (int r = 0; r < 16; ++r) acc[r] = 0.f;
#pragma unroll
        for (int sl = 0; sl < 4; ++sl) {
#pragma unroll
            for (int rr = 0; rr < 4; ++rr)
#pragma unroll
                for (int jj = 0; jj < 2; ++jj) *(LAS f32x4*)(xs + (4 * wave + rr) * 516 + 4 * lane + 256 * jj) = v[rr][2 * sl + jj];
            __syncthreads();
            const float* wp = wg + (size_t)(512 * sl + 64 * wave + hi) * NEXP + r32;
            const LAS float* xp = xs + r32 * 516 + 64 * wave + hi;
#pragma unroll 8
            for (int st = 0; st < 32; ++st) acc = __builtin_amdgcn_mfma_f32_32x32x2f32(wp[st * 2 * NEXP], xp[2 * st], acc, 0, 0, 0);
            __syncthreads();
        }
#pragma unroll
        for (int r = 0; r < 16; ++r) red[(wave * 32 + r32) * 33 + ((r & 3) + 8 * (r >> 2) + 4 * hi)] = acc[r];
        __syncthreads();
        { const int tk = tid >> 4, e0 = (tid & 15) * 2;
#pragma unroll
          for (int q = 0; q < 2; ++q) { float sm = 0.f;
#pragma unroll
              for (int w8 = 0; w8 < 8; ++w8) sm += red[(w8 * 32 + tk) * 33 + e0 + q];
              lg[tk * 33 + e0 + q] = sm * rsd[tk] + a.in[I_BR][e0 + q]; } }
        __syncthreads();
        if (tid < 32) {
            unsigned taken = 0u; float sv[4]; int si[4];
#pragma unroll
            for (int r = 0; r < 4; ++r) { float bv = -3.0e38f; int bi = 0;
                for (int e = 0; e < NEXP; ++e) { const float x = lg[tid * 33 + e]; if (!((taken >> e) & 1u) && x > bv) { bv = x; bi = e; } }
                sv[r] = bv; si[r] = bi; taken |= 1u << bi; }
            const float e1 = __expf(sv[1] - sv[0]), e2 = __expf(sv[2] - sv[0]), e3 = __expf(sv[3] - sv[0]), inv = 1.0f / (1.0f + e1 + e2 + e3);
#pragma unroll
            for (int r = 0; r < 4; ++r) { sel_e[tid * 4 + r] = si[r]; sel_g[tid * 4 + r] = (r == 0 ? 1.0f : r == 1 ? e1 : r == 2 ? e2 : e3) * inv;
                sel_r[tid * 4 + r] = (int)__hip_atomic_fetch_add(cl + si[r], 1u, __ATOMIC_RELAXED, __HIP_MEMORY_SCOPE_WORKGROUP); }
        }
        __syncthreads();
        if (tid < 32) { const unsigned c = cl[tid]; cl[32 + tid] = c ? __hip_atomic_fetch_add(cnt + 64 * tid, c, __ATOMIC_RELAXED, __HIP_MEMORY_SCOPE_AGENT) : 0u; }
        __syncthreads();
        if (tid < 128) { const int e = sel_e[tid], rank = (int)cl[32 + e] + sel_r[tid], tok = tok0 + (tid >> 2);
            r_e[tok * 4 + (tid & 3)] = e; r_g[tok * 4 + (tid & 3)] = sel_g[tid]; r_rank[tok * 4 + (tid & 3)] = rank; elist[(size_t)e * NTOK + rank] = tok; }
        __syncthreads();
    }
}
__device__ __forceinline__ int moe_build_tiles(const Args& a, LAS unsigned char* lds, int tid) {
    unsigned* ctl = (unsigned*)(a.ws + WS_CTL);
    LAS int* tp = (LAS int*)(lds + MISC_OFF + 1024); LAS int* te = (LAS int*)(lds + TE_OFF); LAS unsigned* cn = (LAS unsigned*)(lds + CNT_OFF);
    if (tid < NEXP) cn[tid] = __hip_atomic_load(ctl + CW_CNT + 64 * tid, __ATOMIC_RELAXED, __HIP_MEMORY_SCOPE_AGENT);
    __syncthreads();
    if (tid == 0) { int s = 0; for (int e = 0; e < NEXP; ++e) { tp[e] = s; s += (int)((cn[e] + 255u) >> 8); } tp[NEXP] = s; }
    __syncthreads();
    for (int e = 0; e < NEXP; ++e) { const int lo = tp[e], hi = tp[e + 1]; for (int t = lo + tid; t < hi; t += 512) te[t] = e; }
    __syncthreads();
    return tp[NEXP];
}
__device__ __forceinline__ void phase7(const Args& a, LAS unsigned char* lds, int vcu, int G, int tid, int lane, int wave) {
    unsigned char* ws = a.ws;
    unsigned* ctl = (unsigned*)(ws + WS_CTL);
    LAS int* tp = (LAS int*)(lds + MISC_OFF + 1024);
    { LAS unsigned* cn = (LAS unsigned*)(lds + CNT_OFF);
      if (tid < NEXP) cn[tid] = __hip_atomic_load(ctl + CW_CNT + 64 * tid, __ATOMIC_RELAXED, __HIP_MEMORY_SCOPE_AGENT);
      __syncthreads();
      if (tid == 0) { int s = 0; for (int e = 0; e < NEXP; ++e) { tp[e] = s; s += (int)((cn[e] + 255u) >> 8); } tp[NEXP] = s; } }
    __syncthreads();
    const int gw = vcu * NWAVES + wave, NGW = G * NWAVES;
    const int* r_e = (const int*)(ws + WS_ROUTE); const float* r_g = (const float*)(ws + WS_ROUTE + 256 * 1024); const int* r_rank = (const int*)(ws + WS_ROUTE + 512 * 1024);
    f32x4 gfin[8];
    { const f32x4* gr = (const f32x4*)a.in[I_GFIN] + 2 * lane;
#pragma unroll
      for (int j = 0; j < 4; ++j) { gfin[2 * j] = gr[128 * j]; gfin[2 * j + 1] = gr[128 * j + 1]; } }
    int e_c[4], rk_c[4]; float g_c[4]; v4u h_c[4];
    { const int t0 = gw < NTOK ? gw : NTOK - 1; const v4u* hr = (const v4u*)((const bf16*)(ws + WS_U) + (size_t)t0 * DM) + lane;
#pragma unroll
      for (int r = 0; r < 4; ++r) { e_c[r] = r_e[t0 * 4 + r]; rk_c[r] = r_rank[t0 * 4 + r]; g_c[r] = r_g[t0 * 4 + r]; }
#pragma unroll
      for (int j = 0; j < 4; ++j) h_c[j] = hr[64 * j]; }
    for (int tok = gw; tok < NTOK; tok += NGW) {
        v4u y[4][4];
#pragma unroll
        for (int r = 0; r < 4; ++r) { const size_t pos = (size_t)tp[e_c[r]] * 256 + rk_c[r]; const v4u* yr = (const v4u*)((const bf16*)(ws + WS_YS) + pos * DM) + lane;
#pragma unroll
            for (int j = 0; j < 4; ++j) y[r][j] = yr[64 * j]; }
        int e_n[4], rk_n[4]; float g_n[4]; v4u h_n[4];
        { const int tn = tok + NGW < NTOK ? tok + NGW : NTOK - 1; const v4u* hr = (const v4u*)((const bf16*)(ws + WS_U) + (size_t)tn * DM) + lane;
#pragma unroll
          for (int r = 0; r < 4; ++r) { e_n[r] = r_e[tn * 4 + r]; rk_n[r] = r_rank[tn * 4 + r]; g_n[r] = r_g[tn * 4 + r]; }
#pragma unroll
          for (int j = 0; j < 4; ++j) h_n[j] = hr[64 * j]; }
        float v[4][8];
#pragma unroll
        for (int j = 0; j < 4; ++j) { const v4u hw = h_c[j];
            v[j][0] = bflo(hw.x); v[j][1] = bfhi(hw.x); v[j][2] = bflo(hw.y); v[j][3] = bfhi(hw.y); v[j][4] = bflo(hw.z); v[j][5] = bfhi(hw.z); v[j][6] = bflo(hw.w); v[j][7] = bfhi(hw.w); }
#pragma unroll
        for (int r = 0; r < 4; ++r) { const float gte = g_c[r];
#pragma unroll
            for (int j = 0; j < 4; ++j) { const v4u w = y[r][j];
                v[j][0] += gte * bflo(w.x); v[j][1] += gte * bfhi(w.x); v[j][2] += gte * bflo(w.y); v[j][3] += gte * bfhi(w.y);
                v[j][4] += gte * bflo(w.z); v[j][5] += gte * bfhi(w.z); v[j][6] += gte * bflo(w.w); v[j][7] += gte * bfhi(w.w); } }
#pragma unroll
        for (int r = 0; r < 4; ++r) { e_c[r] = e_n[r]; rk_c[r] = rk_n[r]; g_c[r] = g_n[r]; h_c[r] = h_n[r]; }
        float s = 0.f;
#pragma unroll
        for (int j = 0; j < 4; ++j)
#pragma unroll
            for (int q = 0; q < 8; ++q) s += v[j][q] * v[j][q];
        const float rstd = 1.0f / sqrtf(wave_sum(s) * (1.f / DM) + RMS_EPS);
        f32x4* xr = (f32x4*)(a.out + (size_t)tok * DM) + 2 * lane;
#pragma unroll
        for (int j = 0; j < 4; ++j) { const f32x4 g0 = gfin[2 * j], g1 = gfin[2 * j + 1];
            xr[128 * j] = (f32x4){v[j][0] * rstd * g0.x, v[j][1] * rstd * g0.y, v[j][2] * rstd * g0.z, v[j][3] * rstd * g0.w};
            xr[128 * j + 1] = (f32x4){v[j][4] * rstd * g1.x, v[j][5] * rstd * g1.y, v[j][6] * rstd * g1.z, v[j][7] * rstd * g1.w}; }
    }
}
namespace att {
using s16x4 = __attribute__((ext_vector_type(4))) short;
#define KSWZ(row, colB) ((row) * 256 + ((colB) ^ (((row) & 7) << 4)))
#define SBAR() __builtin_amdgcn_sched_barrier(0)
__device__ __forceinline__ int crow(int r, int hi) { return (r & 3) + 8 * (r >> 2) + 4 * hi; }
__device__ __forceinline__ unsigned cvtpk(float lo, float hi) { return cvt2bf(lo, hi); }
__device__ __forceinline__ int v_st(int k, int c) { const int kk = (k & ~0xC) | ((k & 4) << 1) | ((k & 8) >> 1); return ((kk >> 3) * 4 + (c >> 5)) * 512 + ((kk & 7) * 32 + (c & 31)) * 2; }
__device__ __forceinline__ int v_rd_base(int lane) { return ((lane & 3) << 3) | (((lane >> 2) & 3) << 6) | (((lane >> 4) & 1) << 5) | (((lane >> 5) & 1) << 8); }
constexpr int v_rd_off(int d0, int ks, int half) { return d0 * 512 + ks * 4096 + half * 2048; }
template <int OFF> __device__ __forceinline__ s16x4 tr_read(int vb) { s16x4 r; asm volatile("ds_read_b64_tr_b16 %0, %1 offset:%2" : "=&v"(r) : "v"(vb), "i"(OFF) : "memory"); return r; }
#define ATT_RDK(X, KS) do { X##0 = tr_read<v_rd_off(0, KS, 0)>(vb); X##1 = tr_read<v_rd_off(0, KS, 1)>(vb); X##2 = tr_read<v_rd_off(1, KS, 0)>(vb); X##3 = tr_read<v_rd_off(1, KS, 1)>(vb); \
    X##4 = tr_read<v_rd_off(2, KS, 0)>(vb); X##5 = tr_read<v_rd_off(2, KS, 1)>(vb); X##6 = tr_read<v_rd_off(3, KS, 0)>(vb); X##7 = tr_read<v_rd_off(3, KS, 1)>(vb); } while (0)
#define ATT_PKV(L, H) (bf16x8){L[0], L[1], L[2], L[3], H[0], H[1], H[2], H[3]}
#define ATT_MMAK(PA, X) do { o[0] = __builtin_amdgcn_mfma_f32_32x32x16_bf16(PA, ATT_PKV(X##0, X##1), o[0], 0, 0, 0); o[1] = __builtin_amdgcn_mfma_f32_32x32x16_bf16(PA, ATT_PKV(X##2, X##3), o[1], 0, 0, 0); \
    o[2] = __builtin_amdgcn_mfma_f32_32x32x16_bf16(PA, ATT_PKV(X##4, X##5), o[2], 0, 0, 0); o[3] = __builtin_amdgcn_mfma_f32_32x32x16_bf16(PA, ATT_PKV(X##6, X##7), o[3], 0, 0, 0); } while (0)
__device__ __forceinline__ void pv_pipe(f32x16* o, int vb, bf16x8 pa0, bf16x8 pa1, bf16x8 pa2, bf16x8 pa3) {
    s16x4 a0, a1, a2, a3, a4, a5, a6, a7, b0, b1, b2, b3, b4, b5, b6, b7;
    SBAR(); ATT_RDK(a, 0); ATT_RDK(b, 1);
    asm volatile("s_waitcnt lgkmcnt(8)" ::: "memory"); SBAR(); ATT_MMAK(pa0, a);
    SBAR(); ATT_RDK(a, 2);
    asm volatile("s_waitcnt lgkmcnt(8)" ::: "memory"); SBAR(); ATT_MMAK(pa1, b);
    SBAR(); ATT_RDK(b, 3);
    asm volatile("s_waitcnt lgkmcnt(8)" ::: "memory"); SBAR(); ATT_MMAK(pa2, a);
    asm volatile("s_waitcnt lgkmcnt(0)" ::: "memory"); SBAR(); ATT_MMAK(pa3, b);
}
template <int BLK> __device__ __forceinline__ void pv_half(f32x16* o, int vb, bf16x8 paA, bf16x8 paB) {
    s16x4 a0, a1, a2, a3, a4, a5, a6, a7, b0, b1, b2, b3, b4, b5, b6, b7;
    SBAR(); ATT_RDK(a, 2 * BLK); ATT_RDK(b, 2 * BLK + 1);
    asm volatile("s_waitcnt lgkmcnt(8)" ::: "memory"); SBAR(); ATT_MMAK(paA, a);
    asm volatile("s_waitcnt lgkmcnt(0)" ::: "memory"); SBAR(); ATT_MMAK(paB, b);
}
#define ATT_PK4(P, BASE, OUT) do { unsigned a0_ = cvtpk(P[BASE + 0], P[BASE + 1]), a1_ = cvtpk(P[BASE + 2], P[BASE + 3]);   \
    unsigned b0_ = cvtpk(P[BASE + 4], P[BASE + 5]), b1_ = cvtpk(P[BASE + 6], P[BASE + 7]);                              \
    auto r0_ = __builtin_amdgcn_permlane32_swap(a0_, b0_, false, false); auto r1_ = __builtin_amdgcn_permlane32_swap(a1_, b1_, false, false); \
    v4u w_ = {r0_[0], r1_[0], r0_[1], r1_[1]}; OUT = *reinterpret_cast<bf16x8*>(&w_); } while (0)

constexpr int SHM_T = 16384;
struct AttDma { unsigned ko[2], vo[2]; };
__device__ __forceinline__ AttDma att_dma_init(int wave, int lane) {
    AttDma d;
#pragma unroll
    for (int i = 0; i < 2; ++i) { const int c = wave + 8 * i;
        { const int row = 4 * c + (lane >> 4), ch = (lane & 15) ^ (row & 7); d.ko[i] = (unsigned)(row * HW + ch * 8) * 2u; }
        { const int st = 2 * c + (lane >> 5), kk = (st >> 2) * 8 + ((lane & 31) >> 2), col = (st & 3) * 32 + 8 * (lane & 3);
          const int k = (kk & ~0xC) | ((kk & 4) << 1) | ((kk & 8) >> 1); d.vo[i] = (unsigned)(k * HW + col) * 2u; } }
    return d;
}
__device__ __forceinline__ void att_dma(const AttDma& d, const bf16* __restrict__ Kh, const bf16* __restrict__ Vh, int key0, LAS unsigned char* Kdst, LAS unsigned char* Vdst, int wave) {
    const __amdgpu_buffer_rsrc_t rk = __builtin_amdgcn_make_buffer_rsrc((void*)Kh, 0, 0x7fffffff, 0x00020000), rv = __builtin_amdgcn_make_buffer_rsrc((void*)Vh, 0, 0x7fffffff, 0x00020000);
    const int so = key0 * HW * 2;
#pragma unroll
    for (int i = 0; i < 2; ++i) { const int c = wave + 8 * i;
        __builtin_amdgcn_raw_ptr_buffer_load_lds(rk, (LAS void*)(Kdst + c * 1024), 16, (int)d.ko[i], so, 0, 0);
        __builtin_amdgcn_raw_ptr_buffer_load_lds(rv, (LAS void*)(Vdst + c * 1024), 16, (int)d.vo[i], so, 0, 0); }
}
__device__ __forceinline__ float half_sum32(float v) {
    v += __builtin_bit_cast(float, __builtin_amdgcn_update_dpp(0, __builtin_bit_cast(int, v), 0xB1, 0xf, 0xf, false));
    v += __builtin_bit_cast(float, __builtin_amdgcn_update_dpp(0, __builtin_bit_cast(int, v), 0x4E, 0xf, 0xf, false));
    v += __builtin_bit_cast(float, __builtin_amdgcn_update_dpp(0, __builtin_bit_cast(int, v), 0x141, 0xf, 0xf, false));
    v += __builtin_bit_cast(float, __builtin_amdgcn_update_dpp(0, __builtin_bit_cast(int, v), 0x140, 0xf, 0xf, false));
    return v + __shfl_xor(v, 16);
}
__device__ __forceinline__ void park2(LAS unsigned char* stg, int r, int hi, int r32, int d, float y0, float y1) {
    const unsigned w = cvt2bf(y0, y1); LAS unsigned char* rp = stg + crow(r, hi) * 256 + 2 * r32;
    *(LAS bf16*)(rp + 64 * (d ^ hi)) = (bf16)(w & 0xffffu); *(LAS bf16*)(rp + 64 * ((d + 1) ^ hi)) = (bf16)(w >> 16);
}
__device__ __forceinline__ void store_rows(const LAS unsigned char* stg, bf16* __restrict__ dst  , int lane) {
#pragma unroll
    for (int i = 0; i < 8; ++i) { const int row = (lane >> 4) + 4 * i, pc = lane & 15;
        const v4u w = *(const LAS v4u*)(stg + row * 256 + ((pc * 16) ^ ((i & 1) << 6)));
        *(v4u*)(dst + (size_t)row * DM + pc * 8) = w; }
}
__device__ __forceinline__ void da_unit(LAS unsigned char* lds, const bf16* __restrict__ Q, const bf16* __restrict__ Kp, const bf16* __restrict__ Vp, const float* __restrict__ gda, float lam,
                                        bf16* __restrict__ mixed, int b, int h, int qt, int tid, int wave, int lane) {
    constexpr float THR2 = 8.0f * 1.4426950408889634f;
    const int r32 = lane & 31, hi = lane >> 5, rg = wave & 3, comp = wave >> 2;
    LAS unsigned char* V_lds = lds; LAS unsigned char* K_lds = lds + 4 * SHM_T; LAS float* X = (LAS float*)lds;
    LAS float* wsf = (LAS float*)(lds + MISC_OFF + 2048) + wave * 64; LAS float* li_l = wsf; LAS float* al_l = wsf + 32;
    const int m0 = b * SEQ + 128 * qt;
    bf16x8 qr[4];
    { const bf16* Qw = Q + (size_t)(m0 + 32 * rg + r32) * HW + h * 128 + comp * 64 + hi * 8;
#pragma unroll
      for (int d0 = 0; d0 < 4; ++d0) qr[d0] = *(const bf16x8*)(Qw + d0 * 16); }
    const bf16* Kh = Kp + (size_t)(b * LPB) * HW + h * 128; const bf16* Vh = Vp + (size_t)(b * LPB) * HW + h * 128;
    const int vb0 = (int)(unsigned)(uintptr_t)V_lds + v_rd_base(lane);
    const int NT = 2 * qt + 3, NTw = 2 * qt + 2 + (rg >> 1);
    const AttDma dm = att_dma_init(wave, lane);
    att_dma(dm, Kh, Vh, 0, K_lds, V_lds, wave);
    att_dma(dm, Kh, Vh, 64, K_lds + SHM_T, V_lds + SHM_T, wave);
    int kbuf = 0;
    float m_reg = 0.f, l_reg = 0.f; f32x16 o[4];
    f32x16 mneg;
#pragma unroll
    for (int r = 0; r < 16; ++r) mneg[r] = 0.f;
#pragma unroll
    for (int d = 0; d < 4; ++d)
#pragma unroll
        for (int r = 0; r < 16; ++r) o[d][r] = 0.f;
    bf16x8 pa0, pa1, pa2, pa3; bool pend = false; int pbuf = 0, vbuf = 0;
#pragma unroll
    for (int q = 0; q < 8; ++q) { pa0[q] = 0; pa1[q] = 0; pa2[q] = 0; pa3[q] = 0; }
    for (int j = 0; j < NT; ++j) {
        const int buf = kbuf;
        if (j + 1 < NT) asm volatile("s_waitcnt vmcnt(4)" ::: "memory"); else asm volatile("s_waitcnt vmcnt(0)" ::: "memory");
        __syncthreads();
        if (j + 2 < NT) att_dma(dm, Kh, Vh, (j + 2) * 64, K_lds + (kbuf == 0 ? 2 : kbuf - 1) * SHM_T, V_lds + ((vbuf + 2) & 3) * SHM_T, wave);
        if (comp == 1 && pend) { pv_pipe(o, vb0 + pbuf * SHM_T, pa0, pa1, pa2, pa3); pend = false; }
        if (j < NTw) {
            f32x16 p0 = mneg, p1 = mneg;
            { const LAS unsigned char* Ks = K_lds + buf * SHM_T; bf16x8 kb0[4], kb1[4];
#pragma unroll
              for (int d0 = 0; d0 < 4; ++d0) { const int cb = (comp * 64 + d0 * 16 + hi * 8) * 2;
                  kb0[d0] = *(const LAS bf16x8*)(Ks + KSWZ(r32, cb)); kb1[d0] = *(const LAS bf16x8*)(Ks + KSWZ(32 + r32, cb)); }
              SBAR();
#pragma unroll
              for (int d0 = 0; d0 < 4; ++d0) { p0 = __builtin_amdgcn_mfma_f32_32x32x16_bf16(kb0[d0], qr[d0], p0, 0, 0, 0); p1 = __builtin_amdgcn_mfma_f32_32x32x16_bf16(kb1[d0], qr[d0], p1, 0, 0, 0); } }
            if (j == 0) {
#pragma unroll
                for (int r = 0; r < 16; ++r) p0[r] = -INFINITY;
#pragma unroll
                for (int r = 0; r < 8; ++r) p1[r] = -INFINITY;
            }
            float pmax = p0[0];
#pragma unroll
            for (int r = 1; r < 16; ++r) pmax = fmaxf(pmax, p0[r]);
#pragma unroll
            for (int r = 0; r < 16; ++r) pmax = fmaxf(pmax, p1[r]);
            { auto rr = __builtin_amdgcn_permlane32_swap(__builtin_bit_cast(unsigned, pmax), __builtin_bit_cast(unsigned, pmax), false, false);
              pmax = fmaxf(__builtin_bit_cast(float, rr[0]), __builtin_bit_cast(float, rr[1])); }
            float alpha = 1.f;
            if (j == 0 || !__all(pmax <= THR2)) {
                const float dl = j == 0 ? pmax : fmaxf(pmax, 0.f);
                alpha = j == 0 ? 1.f : __builtin_amdgcn_exp2f(-dl); m_reg += dl;
#pragma unroll
                for (int r = 0; r < 16; ++r) { p0[r] -= dl; p1[r] -= dl; mneg[r] = -m_reg; }
            }
#pragma unroll
            for (int r = 0; r < 16; ++r) { p0[r] = __builtin_amdgcn_exp2f(p0[r]); p1[r] = __builtin_amdgcn_exp2f(p1[r]); }
            if (__any(alpha < 1.f)) { if (hi == 0) al_l[r32] = alpha; asm volatile("s_waitcnt lgkmcnt(0)" ::: "memory");
#pragma unroll
                for (int r = 0; r < 16; ++r) { const float al = al_l[crow(r, hi)];
#pragma unroll
                    for (int d = 0; d < 4; ++d) o[d][r] *= al; } }
            float ps = 0.f;
#pragma unroll
            for (int r = 0; r < 16; ++r) ps += p0[r];
#pragma unroll
            for (int r = 0; r < 16; ++r) ps += p1[r];
            { auto rr = __builtin_amdgcn_permlane32_swap(__builtin_bit_cast(unsigned, ps), __builtin_bit_cast(unsigned, ps), false, false);
              ps = __builtin_bit_cast(float, rr[0]) + __builtin_bit_cast(float, rr[1]); }
            l_reg = l_reg * alpha + ps;
            ATT_PK4(p0, 0, pa0); ATT_PK4(p0, 8, pa1); ATT_PK4(p1, 0, pa2); ATT_PK4(p1, 8, pa3);
            if (comp == 0) pv_pipe(o, vb0 + vbuf * SHM_T, pa0, pa1, pa2, pa3); else { pend = true; pbuf = vbuf; }
        }
        vbuf = (vbuf + 1) & 3; kbuf = kbuf == 2 ? 0 : kbuf + 1;
    }
    if (pend) pv_pipe(o, vb0 + pbuf * SHM_T, pa0, pa1, pa2, pa3);
    if (hi == 0) li_l[r32] = l_reg;
    asm volatile("s_waitcnt lgkmcnt(0)" ::: "memory");
    float rli[16];
#pragma unroll
    for (int r = 0; r < 16; ++r) rli[r] = __builtin_amdgcn_rcpf(li_l[crow(r, hi)]);
    __syncthreads();
    if (comp == 1) {
#pragma unroll
        for (int r = 0; r < 16; ++r) { const float f = rli[r] * lam;
#pragma unroll
            for (int d = 0; d < 4; ++d) X[(rg * 32 + crow(r, hi)) * 128 + 32 * d + r32] = o[d][r] * f; }
    }
    __syncthreads();
    if (comp == 0) {
        float gg[4];
#pragma unroll
        for (int d = 0; d < 4; ++d) gg[d] = gda[h * 128 + 32 * d + r32] * (1.0f - LAM_INIT);
        LAS unsigned char* stg = lds + 4 * SHM_T + rg * 8192;
#pragma unroll
        for (int r = 0; r < 16; ++r) { float ss = 0.f; float v[4];
#pragma unroll
            for (int d = 0; d < 4; ++d) { v[d] = o[d][r] * rli[r] - X[(rg * 32 + crow(r, hi)) * 128 + 32 * d + r32]; ss += v[d] * v[d]; }
            ss = half_sum32(ss);
            const float rs = __builtin_amdgcn_rsqf(ss * (1.f / 128.f) + RMS_EPS);
            park2(stg, r, hi, r32, 0, v[0] * rs * gg[0], v[1] * rs * gg[1]); park2(stg, r, hi, r32, 2, v[2] * rs * gg[2], v[3] * rs * gg[3]); }
        store_rows(stg, mixed + (size_t)(m0 + 32 * rg) * DM + 1024 + h * 128, lane);
    }
    __syncthreads();
}

constexpr float SB_THR2 = -155.0f;
__device__ __forceinline__ void sb_block(f32x16& p, float& running, int kofs, int lo, int lim, bool need_mask, int hi) {
    constexpr float C1 = 0.08838834764831845f * 1.4426950408889634f;
    float L[16];
#pragma unroll
    for (int r = 0; r < 16; ++r) { const float z2 = p[r] * C1, t = __builtin_amdgcn_exp2f(-fabsf(z2)); const float sp = fmaxf(z2, 0.f) + __builtin_amdgcn_logf(1.0f + t);
        const int kk = kofs + crow(r, hi); const bool valid = !need_mask || (kk >= lo && kk < lim);
        L[r] = valid ? -sp : 0.f; p[r] = valid ? z2 : -1.0e30f; }
    float G[4], PG[4];
#pragma unroll
    for (int g = 0; g < 4; ++g) { G[g] = (L[4 * g] + L[4 * g + 1]) + (L[4 * g + 2] + L[4 * g + 3]); PG[g] = __shfl_xor(G[g], 32); }
#pragma unroll
    for (int g = 3; g >= 0; --g) { const float off = running + (hi == 0 ? PG[g] : 0.f);
        const float c3 = L[4 * g + 3] + off, c2 = L[4 * g + 2] + c3, c1 = L[4 * g + 1] + c2, c0 = L[4 * g] + c1;
        p[4 * g + 3] = __builtin_amdgcn_exp2f(p[4 * g + 3] + c3); p[4 * g + 2] = __builtin_amdgcn_exp2f(p[4 * g + 2] + c2);
        p[4 * g + 1] = __builtin_amdgcn_exp2f(p[4 * g + 1] + c1); p[4 * g] = __builtin_amdgcn_exp2f(p[4 * g] + c0);
        running += G[g] + PG[g]; }
}
__device__ __forceinline__ void sb_unit(LAS unsigned char* lds, const bf16* __restrict__ Q, const bf16* __restrict__ Kp, const bf16* __restrict__ Vp, const float* __restrict__ gsb,
                                        bf16* __restrict__ mixed, int b, int h, int qt, int tid, int wave, int lane) {
    const int r32 = lane & 31, hi = lane >> 5;
    LAS unsigned char* V_lds = lds; LAS unsigned char* K_lds = lds + 2 * SHM_T;
    LAS unsigned* fl = (LAS unsigned*)(lds + MISC_OFF + 4096);
    const int m0 = b * SEQ + 256 * qt;
    LAS unsigned char* Qs = lds + 4 * SHM_T + wave * 8192;
    { const bf16* Qw = Q + (size_t)(m0 + 32 * wave + r32) * HW + h * 128 + hi * 8;
#pragma unroll
      for (int d0 = 0; d0 < 8; ++d0) { const bf16x8 qv = *(const bf16x8*)(Qw + d0 * 16); *(LAS bf16x8*)(Qs + KSWZ(r32, (d0 * 16 + hi * 8) * 2)) = qv; } }
    const bf16* Kh = Kp + (size_t)(b * LPB) * HW + h * 128; const bf16* Vh = Vp + (size_t)(b * LPB) * HW + h * 128;
    const int vb0 = (int)(unsigned)(uintptr_t)V_lds + v_rd_base(lane);
    int kb[4];
#pragma unroll
    for (int bq = 0; bq < 4; ++bq) kb[bq] = r32 * 256 + ((bq * 32 + hi * 16) ^ ((r32 & 7) << 4));
    const int jtop = 4 * qt + 4, jw = 4 * qt + 1 + (wave >> 1);
    const int Prow = 64 + 256 * qt + 32 * wave + r32;
    if (lane == 0) { fl[wave] = 0u; fl[8 + wave] = 0u; }
    { const AttDma dm = att_dma_init(wave, lane); att_dma(dm, Kh, Vh, jtop * 64, K_lds, V_lds, wave); }
    float carry = 0.f; bool done = false; f32x16 o[4];
#pragma unroll
    for (int d = 0; d < 4; ++d)
#pragma unroll
        for (int r = 0; r < 16; ++r) o[d][r] = 0.f;
    for (int j = jtop, it = 0; j >= 0; --j, ++it) {
        const int buf = it & 1;
        asm volatile("s_waitcnt vmcnt(0)" ::: "memory");
        __syncthreads();
        if (it > 0) { const v4u f0 = *(const LAS v4u*)(fl + ((it - 1) & 1) * 8), f1 = *(const LAS v4u*)(fl + ((it - 1) & 1) * 8 + 4);
            if ((f0.x & f0.y & f0.z & f0.w & f1.x & f1.y & f1.z & f1.w) != 0u) break; }
        if (j > 0) { int z = 0; asm volatile("" : "+v"(z));
            const AttDma dm = att_dma_init(wave, lane + z); att_dma(dm, Kh, Vh, (j - 1) * 64, K_lds + (buf ^ 1) * SHM_T, V_lds + (buf ^ 1) * SHM_T, wave); }
        if (!done && j <= jw) {
            const bool need_mask = (j == jw) || (j == 0);
            const int lim = Prow - 64 * j, lo = (j == 0) ? KVPAD : 0;
            float running = carry;
            const LAS unsigned char* Ks = K_lds + buf * SHM_T;
            {   f32x16 p;
#pragma unroll
                for (int r = 0; r < 16; ++r) p[r] = 0.f;
#pragma unroll
                for (int d0 = 0; d0 < 8; ++d0) { const int ko = kb[d0 & 3] + (d0 >> 2) * 128;
                    const bf16x8 b1 = *(const LAS bf16x8*)(Ks + ko + 8192), qv = *(const LAS bf16x8*)(Qs + ko); p = __builtin_amdgcn_mfma_f32_32x32x16_bf16(b1, qv, p, 0, 0, 0); }
                sb_block(p, running, 32, lo, lim, need_mask, hi);
                bf16x8 paA, paB; ATT_PK4(p, 0, paA); ATT_PK4(p, 8, paB);
                pv_half<1>(o, vb0 + buf * SHM_T, paA, paB); }
            SBAR();
            {   f32x16 p;
#pragma unroll
                for (int r = 0; r < 16; ++r) p[r] = 0.f;
#pragma unroll
                for (int d0 = 0; d0 < 8; ++d0) { const int ko = kb[d0 & 3] + (d0 >> 2) * 128;
                    const bf16x8 b0 = *(const LAS bf16x8*)(Ks + ko), qv = *(const LAS bf16x8*)(Qs + ko); p = __builtin_amdgcn_mfma_f32_32x32x16_bf16(b0, qv, p, 0, 0, 0); }
                sb_block(p, running, 0, lo, lim, need_mask, hi);
                bf16x8 paA, paB; ATT_PK4(p, 0, paA); ATT_PK4(p, 8, paB);
                pv_half<0>(o, vb0 + buf * SHM_T, paA, paB); }
            carry = running;
            done = __all(carry < SB_THR2);
        }
        if (lane == 0) fl[(it & 1) * 8 + wave] = done ? 1u : 0u;
    }
    { float gg[4];
#pragma unroll
      for (int d = 0; d < 4; ++d) gg[d] = gsb[h * 128 + 32 * d + r32];
#pragma unroll
      for (int r = 0; r < 16; ++r) { float ss = 0.f;
#pragma unroll
          for (int d = 0; d < 4; ++d) ss += o[d][r] * o[d][r];
          ss = half_sum32(ss);
          const float rs = __builtin_amdgcn_rsqf(ss * (1.f / 128.f) + RMS_EPS);
          park2(Qs, r, hi, r32, 0, o[0][r] * rs * gg[0], o[1][r] * rs * gg[1]); park2(Qs, r, hi, r32, 2, o[2][r] * rs * gg[2], o[3][r] * rs * gg[3]); }
      store_rows(Qs, mixed + (size_t)(m0 + 32 * wave) * DM + h * 128, lane); }
    __syncthreads();
}
}

__device__ __forceinline__ void phase_attn(const Args& a, LAS unsigned char* lds, int vcu, int G, int tid, int lane, int wave) {
    unsigned char* ws = a.ws;
    const float lam = ((const float*)(ws + WS_CTL))[CW_LAM];
    for (int idx = vcu; idx < 256; idx += G) {
        const int s16 = idx & 15;
        for (int k = 0; k < 4; ++k) { const int bh = ((idx >> 5) << 2) + 2 * (k >> 1) + ((idx >> 4) & 1), b = bh >> 3, h = bh & 7, qt = (k & 1) ? 31 - s16 : s16;
            att::da_unit(lds, (const bf16*)(ws + WS_DAQ), (const bf16*)(ws + WS_DAK), (const bf16*)(ws + WS_DAV), a.in[I_GDA], lam, (bf16*)(ws + WS_MIX), b, h, qt, tid, wave, lane); }
    }
    for (int idx = vcu; idx < 256; idx += G) {
        const int bh = idx >> 3, s = idx & 7, b = bh >> 3, h = bh & 7;
        for (int k = 0; k < 2; ++k)
            att::sb_unit(lds, (const bf16*)(ws + WS_SBQ), (const bf16*)(ws + WS_SBK), (const bf16*)(ws + WS_SBV), a.in[I_GSB], (bf16*)(ws + WS_MIX), b, h, 2 * s + k, tid, wave, lane);
    }
}

enum { PH_PRO = 0, PH_INPROJ, PH_ATTN, PH_OUTPROJ, PH_ROUTE, PH_GATEUP, PH_DOWN, PH_FINAL, PH_N };
__global__ void __launch_bounds__(NWAVES * 64, 2) fwd(Args args) {
    extern __shared__ __attribute__((aligned(16))) unsigned char lds_raw[];
    LAS unsigned char* lds = (LAS unsigned char*)lds_raw;
    const int tid = threadIdx.x, lane = tid & 63, wave = __builtin_amdgcn_readfirstlane(tid >> 6);
    const int G = gridDim.x; const int bx = blockIdx.x; const int vcu = (G % 8 == 0) ? (bx % 8) * (G / 8) + bx / 8 : bx;
    unsigned char* ws = args.ws;
    unsigned* ctl = (unsigned*)(ws + WS_CTL);
    volatile LAS unsigned* MISC = (volatile LAS unsigned*)(lds + MISC_OFF);
    if (tid < 64) MISC[tid] = 0u;
    __syncthreads();
    XcdBarrier bar; bar.bar = ctl + CW_BAR; bar.x = 0; bar.st = MISC + 8;
    const int lo = args.ph_lo, hi = args.ph_hi;
    if (hi - lo > 1) bar = xcd_barrier_post(ctl + CW_BAR, MISC + 8);
#define IN(k) (lo <= (k) && (k) < hi)
#define SEAM(k) do { if (IN(k) && IN((k) + 1)) xcd_barrier(bar); } while (0)

    if (IN(PH_PRO)) { for (int rep = 0; rep < REP_PRO; ++rep) phase0(args, lds, vcu, G, tid, lane, wave); SEAM(PH_PRO); }
    if (IN(PH_INPROJ)) {
        pg8::DenseOrder S; S.init((const bf16*)(ws + WS_U), (const bf16*)(ws + WS_WIN), NTOK, INCOLS, G, bx);
        pg8::EpiProj E{(bf16*)(ws + WS_SBQ), (bf16*)(ws + WS_SBK), (bf16*)(ws + WS_SBV), (bf16*)(ws + WS_DAQ), (bf16*)(ws + WS_DAK), (bf16*)(ws + WS_DAV), (const float*)(ws + WS_ROPE)};
        if ((vcu & 1) == 0) conv_slice(args, lds, 0, vcu, G, lane, wave);
        for (int rep = 0; rep < REP_INPROJ; ++rep) pg8::gemm_phase<pg8::EpiProj, pg8::DenseOrder>(lds, S, E);
        if ((vcu & 1) != 0) conv_slice(args, lds, 0, vcu, G, lane, wave);
        SEAM(PH_INPROJ);
    }
    if (IN(PH_ATTN)) { if ((vcu & 1) == 0) conv_slice(args, lds, 1, vcu, G, lane, wave);
        for (int rep = 0; rep < REP_ATTN; ++rep) phase_attn(args, lds, vcu, G, tid, lane, wave);
        __syncthreads(); if ((vcu & 1) != 0) conv_slice(args, lds, 1, vcu, G, lane, wave); SEAM(PH_ATTN); }
    if (IN(PH_OUTPROJ)) {
        pg8::DenseOrder S; S.init((const bf16*)(ws + WS_MIX), (const bf16*)(ws + WS_WOUT), NTOK, DM, G, bx);
        pg8::EpiRes E{args.in[I_X], (bf16*)(ws + WS_U)};
        if ((vcu & 1) == 0) conv_slice(args, lds, 2, vcu, G, lane, wave);
        pg8::gemm_phase<pg8::EpiRes, pg8::DenseOrder>(lds, S, E);
        if ((vcu & 1) != 0) conv_slice(args, lds, 2, vcu, G, lane, wave);
        SEAM(PH_OUTPROJ);
    }
    if (IN(PH_ROUTE)) { phase4(args, lds, vcu, G, tid, lane, wave); SEAM(PH_ROUTE); }
    if (IN(PH_GATEUP)) {
        const int ntiles = __builtin_amdgcn_readfirstlane(moe_build_tiles(args, lds, tid));
        pg8::MoeOrder<true> S; S.init((const bf16*)(ws + WS_U2), (const bf16*)(ws + WS_WGU), ntiles, 4096, lds, ctl + CW_QUEUE + 64 * (bx & 7), bx & 7);
        {
            const LAS int* tp = (const LAS int*)(lds + MISC_OFF + 1024); const LAS unsigned* cn = (const LAS unsigned*)(lds + CNT_OFF); const LAS int* te = (const LAS int*)(lds + TE_OFF);
            LAS unsigned short* gidx = (LAS unsigned short*)(lds + IDX_OFF); const int* elist = (const int*)(ws + WS_ELIST);
            const int total = (ntiles - S.mlo < IDX_TILES ? ntiles - S.mlo : IDX_TILES) * 256;
#pragma unroll 4
            for (int q = tid; q < total; q += 512) { const int T = S.mlo + (q >> 8), e = te[T], rank = (T - tp[e]) * 256 + (q & 255); gidx[q] = (unsigned short)elist[(size_t)e * NTOK + (rank < (int)cn[e] ? rank : 0)]; }
        }
        S.prefetch(0); S.prefetch(1); __syncthreads();
        pg8::EpiSwiglu E{(bf16*)(ws + WS_ACT), args.in[I_BGU]};
        {
            const int cut = 2 * (vcu & 7);
#pragma unroll 1
            for (int part = 0; part < 2; ++part) {
                if (part == 1) { int z = 0; asm volatile("" : "+s"(z));
                    conv_slice(args, lds, 3, vcu + z, G, lane + z, wave + z); }
                S.base = part ? (S.ndone < cut ? S.ndone : cut) : 0; S.cap = part ? (1 << 30) : cut;
                S.ndone = 0;
                if (S.cap > 0) pg8::gemm_phase<pg8::EpiSwiglu, pg8::MoeOrder<true>>(lds, S, E);
            }
        }
        SEAM(PH_GATEUP);
    }
    if (IN(PH_DOWN)) {
        const int ntiles = __builtin_amdgcn_readfirstlane(moe_build_tiles(args, lds, tid));
        pg8::MoeOrder<false> S; S.init((const bf16*)(ws + WS_ACT), (const bf16*)(ws + WS_WDN), ntiles, DM, lds, ctl + CW_QUEUE + 64 * (8 + (bx & 7)), bx & 7);
        S.prefetch(0); S.prefetch(1); __syncthreads();
        pg8::EpiDown E{(bf16*)(ws + WS_YS), args.in[I_BDN]};
        for (int rep = 0; rep < REP_DOWN; ++rep) pg8::gemm_phase<pg8::EpiDown, pg8::MoeOrder<false>>(lds, S, E);
        SEAM(PH_DOWN);
    }
    if (IN(PH_FINAL)) { phase7(args, lds, vcu, G, tid, lane, wave); }
#undef IN
#undef SEAM
}

extern "C" void kernel_launch(void* const* d_in, const int* in_sizes, int n_in, void* d_out, int out_size, void* d_ws, size_t ws_size, hipStream_t stream) {
    static int grid = 0;
    if (grid == 0) {
        if (n_in != 19 || out_size != NTOK * DM || ws_size < WS_END) { fprintf(stderr, "kernel_launch: unexpected shapes (n_in %d out %d ws %zu)\n", n_in, out_size, ws_size); grid = -1; return; }
        int dev = 0, cus = 0, per_cu = 0;
        if (hipGetDevice(&dev) != hipSuccess || hipDeviceGetAttribute(&cus, hipDeviceAttributeMultiprocessorCount, dev) != hipSuccess) { grid = -1; return; }
        if (hipFuncSetAttribute((const void*)fwd, hipFuncAttributeMaxDynamicSharedMemorySize, LDS_BYTES) != hipSuccess) { fprintf(stderr, "kernel_launch: hipFuncSetAttribute failed\n"); grid = -1; return; }
        if (hipOccupancyMaxActiveBlocksPerMultiprocessor(&per_cu, (const void*)fwd, NWAVES * 64, LDS_BYTES) != hipSuccess || per_cu < 1) { fprintf(stderr, "kernel_launch: occupancy query says %d\n", per_cu); }
        (void)hipGetLastError();
        grid = cus;
    }
    if (grid < 0) return;
    (void)in_sizes;
    (void)hipMemsetAsync((char*)d_ws + WS_CTL, 0, CTL_ZERO_BYTES, stream);
    Args a{};
    for (int i = 0; i < 19; ++i) a.in[i] = (const float*)d_in[i];
    a.out = (float*)d_out; a.ws = (unsigned char*)d_ws;
#if N_LAUNCH_MODE == 1
    a.ph_lo = 0; a.ph_hi = PH_N;
    hipLaunchKernelGGL(fwd, dim3(grid), dim3(NWAVES * 64), LDS_BYTES, stream, a);
#else
    for (int ph = 0; ph < PH_N; ++ph) {
        a.ph_lo = ph; a.ph_hi = ph + 1;
        hipLaunchKernelGGL(fwd, dim3(grid), dim3(NWAVES * 64), LDS_BYTES, stream, a);
    }
#endif
    const hipError_t le = hipPeekAtLastError();
    if (le != hipSuccess) fprintf(stderr, "kernel_launch: launch failed: %s\n", hipGetErrorName(le));
}
```

```cpp
#include <hip/hip_runtime.h>
#include <cstdio>
#include <cstdint>

#ifndef REP_PRO
#define REP_PRO 1
#endif
#ifndef REP_INPROJ
#define REP_INPROJ 1
#endif
#ifndef REP_ATTN
#define REP_ATTN 1
#endif
#ifndef REP_GU
#define REP_GU 1
#endif
#ifndef REP_DOWN
#define REP_DOWN 1
#endif
#ifndef N_LAUNCH_MODE
#define N_LAUNCH_MODE 1
#endif

constexpr int BATCH = 4, SEQ = 4096, DM = 2048, NTOK = BATCH * SEQ;
constexpr int NMETA = 16, KVPAD = 48, LPB = 4160;
constexpr int HW = 1024;
constexpr int INCOLS = 6144;
constexpr int NEXP = 32, TOPK = 4;
constexpr int MAXTILES = 288, NPADROWS = MAXTILES * 256;
constexpr float RMS_EPS = 1e-5f;
constexpr float LAM_INIT = 0.2f;

constexpr size_t MiB = 1u << 20;
constexpr size_t WS_CTL = 0, CTL_ZERO_BYTES = 1 * MiB;
constexpr size_t WS_ROPE = 1 * MiB;
constexpr size_t WS_WIN = 2 * MiB;
constexpr size_t WS_WOUT = 26 * MiB;
constexpr size_t WS_U = 34 * MiB;
constexpr size_t WS_SBQ = 98 * MiB, WS_DAQ = 130 * MiB;
constexpr size_t WS_SBK = 162 * MiB, WS_SBV = 195 * MiB, WS_DAK = 228 * MiB, WS_DAV = 261 * MiB;
constexpr size_t WS_MIX = 294 * MiB;
constexpr size_t WS_U2 = 358 * MiB;
constexpr size_t WS_ROUTE = 422 * MiB;
constexpr size_t WS_ELIST = 424 * MiB;
constexpr size_t WS_WG = 1 * MiB + 512 * 1024;
constexpr size_t WS_ACT = 712 * MiB;
constexpr size_t WS_YS = 1000 * MiB;
constexpr size_t WS_WGU = 1288 * MiB;
constexpr size_t WS_WDN = 1800 * MiB;
constexpr size_t WS_END = 2056 * MiB;
constexpr int CW_TMO = 0, CW_LAM = 16, CW_NTILES = 32, CW_BAR = 4096, CW_CNT = 8192  , CW_TILE_E = 12288  , CW_QUEUE = 16384  ;

constexpr int LDS_BYTES = 163840;
constexpr int MISC_OFF = 131072;
constexpr int TE_OFF = MISC_OFF + 4608;
constexpr int CNT_OFF = MISC_OFF + 1280;
constexpr int IDX_OFF = MISC_OFF + 8192;
constexpr int IDX_TILES = 48;
constexpr int TICK_OFF = MISC_OFF + 7168;

#define GAS __attribute__((address_space(1)))
#define LAS __attribute__((address_space(3)))
typedef unsigned short bf16;
typedef unsigned v4u __attribute__((ext_vector_type(4)));
typedef unsigned v2u __attribute__((ext_vector_type(2)));
typedef float f32x4 __attribute__((ext_vector_type(4)));
typedef float f32x16 __attribute__((ext_vector_type(16)));
typedef short bf16x8 __attribute__((ext_vector_type(8)));
#define LDS_WAIT() asm volatile("s_waitcnt lgkmcnt(0)" ::: "memory")
#define VM_WAIT() asm volatile("s_waitcnt vmcnt(0)" ::: "memory")

__device__ __forceinline__ unsigned f2bf(float f) { unsigned u = __builtin_bit_cast(unsigned, f); return (u + 0x7fffu + ((u >> 16) & 1u)) >> 16; }
__device__ __forceinline__ unsigned pk2(float lo, float hi) { return f2bf(lo) | (f2bf(hi) << 16); }
__device__ __forceinline__ float bf2f(unsigned short b) { return __builtin_bit_cast(float, (unsigned)b << 16); }
__device__ __forceinline__ float bflo(unsigned w) { return __builtin_bit_cast(float, w << 16); }
__device__ __forceinline__ float bfhi(unsigned w) { return __builtin_bit_cast(float, w & 0xffff0000u); }
typedef __bf16 bf16x2_t __attribute__((ext_vector_type(2)));
typedef float f32x2_t __attribute__((ext_vector_type(2)));
__device__ __forceinline__ unsigned cvt2bf(float lo, float hi) { const f32x2_t v = {lo, hi}; const bf16x2_t r = __builtin_convertvector(v, bf16x2_t); return __builtin_bit_cast(unsigned, r); }
__device__ __forceinline__ float wave_sum(float v) {
#pragma unroll
    for (int o = 1; o < 64; o <<= 1) v += __shfl_xor(v, o);
    return v;
}

#define XB_TMO      128
#define XB_XCNT(j)  (256  + 64 * (j))
#define XB_XSUB(j)  (1280 + 64 * (j))
#define XB_XGEN(j)  (2304 + 64 * (j))
#define XB_TOP      3328
#define XB_TOPGEN   3392
#define XCD_BAR_WORDS 3456
#define XB_SPIN_CAP (1u << 22)
__device__ __forceinline__ unsigned xb_ld(unsigned* p)              { return __hip_atomic_load(p, __ATOMIC_RELAXED, __HIP_MEMORY_SCOPE_AGENT); }
__device__ __forceinline__ unsigned xb_add(unsigned* p, unsigned v) { return __hip_atomic_fetch_add(p, v, __ATOMIC_RELAXED, __HIP_MEMORY_SCOPE_AGENT); }
__device__ __forceinline__ unsigned xb_xcc_id() { return (unsigned)__builtin_amdgcn_s_getreg((3 << 11) | 20) & 0xFu; }
#define XB_SPIN(cond, bar) do { unsigned _sp = 0; while (cond) { __builtin_amdgcn_s_sleep(1); \
    if ((++_sp & 255u) == 0u) { if (xb_ld(&(bar)[XB_TMO])) break; if (_sp > XB_SPIN_CAP) { atomicAdd(&(bar)[XB_TMO], 1u); break; } } } } while (0)
struct XcdBarrier { unsigned* bar; unsigned x; volatile LAS unsigned* st; };
__device__ __forceinline__ XcdBarrier xcd_barrier_post(unsigned* bar, volatile LAS unsigned* st) {
    XcdBarrier b; b.bar = bar; b.x = xb_xcc_id(); b.st = st;
    if (threadIdx.x == 0) (void)xb_add(&bar[XB_XCNT(b.x)], 1u);
    return b;
}
__device__ __forceinline__ void xcd_barrier_complete(unsigned* bar, unsigned x, unsigned& nloc, unsigned& nx) {
    const unsigned G = gridDim.x * gridDim.y * gridDim.z;
    unsigned sum, cnt, mine, sp = 0u;
    for (;;) {
        sum = 0u; cnt = 0u; mine = 0u;
#pragma unroll
        for (unsigned j = 0; j < 16; ++j) { const unsigned c = xb_ld(&bar[XB_XCNT(j)]); sum += c; cnt += (c > 0u) ? 1u : 0u; mine = (j == x) ? c : mine; }
        if (sum == G) break;
        __builtin_amdgcn_s_sleep(1);
        if ((++sp & 255u) == 0u) { if (xb_ld(&bar[XB_TMO])) break; if (sp > XB_SPIN_CAP) { atomicAdd(&bar[XB_TMO], 1u); break; } }
    }
    nloc = mine > 0u ? mine : 1u; nx = cnt > 0u ? cnt : 1u;
}
__device__ __forceinline__ void xcd_barrier(const XcdBarrier& b) {
    asm volatile("s_waitcnt vmcnt(0)" ::: "memory");
    __syncthreads();
    if (threadIdx.x == 0) {
        unsigned* bar = b.bar;
        __builtin_amdgcn_s_waitcnt(0);
        unsigned nloc = b.st[0], nx = b.st[1];
        if (nloc == 0u) { xcd_barrier_complete(bar, b.x, nloc, nx); b.st[0] = nloc; b.st[1] = nx; }
        const unsigned old = xb_add(&bar[XB_XSUB(b.x)], 1u);
        const unsigned gen = old / nloc;
        if (old + 1u == (gen + 1u) * nloc) {
            __builtin_amdgcn_fence(__ATOMIC_RELEASE, "agent");
            asm volatile("s_waitcnt vmcnt(0)" ::: "memory");
            const unsigned og = xb_add(&bar[XB_TOP], 1u);
            const unsigned tg = og / nx;
            if (og + 1u == (tg + 1u) * nx) xb_add(&bar[XB_TOPGEN], 1u);
            else XB_SPIN(xb_ld(&bar[XB_TOPGEN]) == tg, bar);
            __builtin_amdgcn_fence(__ATOMIC_ACQUIRE, "agent");
            xb_add(&bar[XB_XGEN(b.x)], 1u);
            asm volatile("s_waitcnt vmcnt(0)" ::: "memory");
        } else {
            XB_SPIN(xb_ld(&bar[XB_XGEN(b.x)]) == gen, bar);
            __builtin_amdgcn_fence(__ATOMIC_ACQUIRE, "agent");
            asm volatile("s_waitcnt vmcnt(0)" ::: "memory");
        }
    }
    __syncthreads();
}

namespace pg8 {
constexpr int BM = 256, BK = 64, HALF = 128, HTB = HALF * BK * 2, STAGE_BYTES = 8 * HTB, NXCD = 8, WGM = 8;
constexpr int KDIM = 2048;
__host__ __device__ __forceinline__ int lds_byte(int r, int c) { const int st = (r >> 4) * 2 + (c >> 5), rr = r & 15, cc = c & 31, ob = rr * 64 + cc * 2; return st * 1024 + (ob ^ (((ob >> 9) & 1) << 5)); }
__host__ __device__ __forceinline__ void stage_rc(int b, int& R, int& C) { const int st = b / 1024, sb = b % 1024, swz = sb ^ (((sb >> 9) & 1) << 5); R = (st >> 1) * 16 + swz / 64; C = (st & 1) * 32 + (swz % 64) / 2; }
__host__ __device__ __forceinline__ int perm32(int rho) { const int n = rho >> 4, i = rho & 15; return 8 * (i >> 2) + 4 * n + (i & 3); }

struct Unit { int pm, pn, e, vr; const char* a; const char* b; };

struct DenseOrder {
    static constexpr bool GATHER = false;
    int nM, nN, nwg, G, c, first = 0, count = 1 << 30; const char* A; const char* Bt;
    __device__ __forceinline__ void prefetch(int) const {}
    __device__ void init(const bf16* A_, const bf16* Bt_, int M, int N, int G_, int c_) { nM = M / BM; nN = N / BM; nwg = nM * nN; G = G_; c = c_; A = (const char*)A_; Bt = (const char*)Bt_; }
    __device__ __forceinline__ bool next(int i, Unit& u) const {
        if (i >= count) return false; i += first;
        const long L = (long)i * G + c; if (L >= nwg) return false;
        int wgid = (int)L; { const int q = nwg / NXCD, r = nwg % NXCD, xcd = wgid % NXCD, off = wgid / NXCD; wgid = (xcd < r ? xcd * (q + 1) : r * (q + 1) + (xcd - r) * q) + off; }
        const int nig = WGM * nN, gid = wgid / nig, fm = gid * WGM, gsz = (nM - fm) < WGM ? (nM - fm) : WGM;
        u.pm = fm + ((wgid % nig) % gsz); u.pn = (wgid % nig) / gsz; u.e = 0; u.vr = BM;
        u.a = A + (size_t)u.pm * (size_t)(BM * KDIM * 2); u.b = Bt + (size_t)u.pn * (size_t)(BM * KDIM * 2); return true;
    }
};
template <bool GATH> struct MoeOrder {
    static constexpr bool GATHER = GATH;
    int nM, nN, nwg, lo, sz, mlo, base = 0, cap = 1 << 30;
    mutable int ndone = 0;
    const char* A; const char* Bt; const LAS int* te; const LAS int* tpx; const LAS unsigned* cnx; LAS int* tick; unsigned* qctr; size_t estride;
    __device__ void init(const bf16* A_, const bf16* Bt_, int ntiles, int NE, LAS unsigned char* lds, unsigned* qctr_, int q8) {
        nM = ntiles; nN = NE / BM; nwg = nM * nN; A = (const char*)A_; Bt = (const char*)Bt_; estride = (size_t)NE * KDIM * 2;
        te = (const LAS int*)(lds + TE_OFF); tpx = (const LAS int*)(lds + MISC_OFF + 1024); cnx = (const LAS unsigned*)(lds + CNT_OFF); tick = (LAS int*)(lds + TICK_OFF); qctr = qctr_;
        const int q = nwg / NXCD, r = nwg % NXCD; lo = q8 < r ? q8 * (q + 1) : r * (q + 1) + (q8 - r) * q; sz = q8 < r ? q + 1 : q;
        mlo = WGM * (lo / (WGM * nN)); }
    __device__ __forceinline__ void decode(int wgid, Unit& u) const {
        const int nig = WGM * nN, gid = wgid / nig, fm = gid * WGM, gsz = (nM - fm) < WGM ? (nM - fm) : WGM;
        u.pm = fm + ((wgid % nig) % gsz); u.pn = (wgid % nig) / gsz;
        u.e = __builtin_amdgcn_readfirstlane(te[u.pm]);
        { const int left = (int)cnx[u.e] - (u.pm - tpx[u.e]) * BM; u.vr = __builtin_amdgcn_readfirstlane(left < BM ? left : BM); }
        u.a = A + (size_t)u.pm * (size_t)(BM * KDIM * 2); u.b = Bt + (size_t)u.e * estride + (size_t)u.pn * (size_t)(BM * KDIM * 2); }
    __device__ __forceinline__ void prefetch(int i) const { if (threadIdx.x == 0) tick[(base + i) & 3] = (int)__hip_atomic_fetch_add(qctr, 1u, __ATOMIC_RELAXED, __HIP_MEMORY_SCOPE_AGENT); }
    __device__ __forceinline__ bool next(int i, Unit& u) const {
        if (i >= cap) return false;
        const int t = __builtin_amdgcn_readfirstlane(tick[(base + i) & 3]); if (t >= sz) return false;
        ndone = i + 1 > ndone ? i + 1 : ndone;
        decode(lo + t, u); return true; }
};

__device__ __forceinline__ unsigned cvt_pk_bf16(float lo, float hi) { return cvt2bf(lo, hi); }

template <class Epi, class Sched>
__device__ __forceinline__ void gemm_phase(LAS unsigned char* lds, const Sched& S, const Epi& E) {
    const int tid = threadIdx.x, wid = __builtin_amdgcn_readfirstlane(tid >> 6), lane = tid & 63, wr = wid >> 2, wc = wid & 3, fr = lane & 15, fq = lane >> 4;
    constexpr int K = KDIM, nt = K / BK;
    unsigned voffA[2], voffB[2];
#pragma unroll
    for (int i = 0; i < 2; ++i) { int R, C; stage_rc(tid * 16 + i * 8192, R, C); const int Rb = Epi::PERM ? ((R & ~31) + perm32(R & 31)) : R;
        voffA[i] = (unsigned)(R * K + C) * 2u; voffB[i] = (unsigned)(Rb * K + C) * 2u; }
    const size_t kstep = (size_t)(BK * 2);
    const size_t hstep = (size_t)HALF * K * 2;
    const unsigned ldsw = (unsigned)wid * 1024u;
    const int aoff = lds_byte(wr * 64 + fr, fq * 8), boff = lds_byte(wc * 32 + fr, fq * 8);
    unsigned vg[2][2] = {{0u, 0u}, {0u, 0u}}, nvg[2][2] = {{0u, 0u}, {0u, 0u}};
    const LAS unsigned short* gidx = (const LAS unsigned short*)(lds + IDX_OFF);
#define PG8_GIDX(dst, u_) do { int mt_ = 0; if constexpr (Sched::GATHER) mt_ = (u_).pm - S.mlo; mt_ = mt_ < 0 ? 0 : (mt_ < IDX_TILES ? mt_ : IDX_TILES - 1); \
    _Pragma("unroll") for (int _i = 0; _i < 2; ++_i) { int R_, C_; stage_rc(tid * 16 + _i * 8192, R_, C_); _Pragma("unroll") for (int _h = 0; _h < 2; ++_h) \
        dst[_h][_i] = (unsigned)gidx[mt_ * 256 + _h * HALF + R_] * (unsigned)(K * 2) + (unsigned)C_ * 2u; } } while (0)
#define PG8_SA(b, h) (((b) * 2 + (h)) * HTB)
#define PG8_SB(b, h) ((4 + (b) * 2 + (h)) * HTB)
#define PG8_STAGE_R(bufoff, gbase, voff, RS, BASE) do { const int so_ = (int)(unsigned)((const char*)(gbase) - (BASE)); _Pragma("unroll") for (int _i = 0; _i < 2; ++_i) \
        __builtin_amdgcn_raw_ptr_buffer_load_lds(RS, (LAS void*)(lds + (bufoff) + ldsw + _i * 8192), 16, (int)(voff)[_i], so_, 0, 0); } while (0)
#define PG8_STAGE(bufoff, gbase, voff) PG8_STAGE_R(bufoff, gbase, voff, rsB, S.Bt)
#define PG8_STAGE_A(bufoff, kofs, h, nx) do { if constexpr (Sched::GATHER) { const int so_ = (int)(unsigned)(kofs); \
        _Pragma("unroll") for (int _i = 0; _i < 2; ++_i) { const unsigned vo_ = (nx) ? nvg[h][_i] : vg[h][_i]; \
            __builtin_amdgcn_raw_ptr_buffer_load_lds(rsA, (LAS void*)(lds + (bufoff) + ldsw + _i * 8192), 16, (int)vo_, so_, 0, 0); } } \
    else { PG8_STAGE_R(bufoff, ((nx) ? nA : cA) + (size_t)(kofs) + (size_t)(h) * hstep, voffA, rsA, S.A); } } while (0)
#define PG8_LDA(dst, b, h) do { _Pragma("unroll") for (int m = 0; m < 4; ++m) _Pragma("unroll") for (int k = 0; k < 2; ++k) dst[m][k] = *(const LAS bf16x8*)(lds + PG8_SA(b, h) + aoff + m * 2048 + k * 1024); } while (0)
#define PG8_LDB(dst, b, h) do { _Pragma("unroll") for (int n = 0; n < 2; ++n) _Pragma("unroll") for (int k = 0; k < 2; ++k) dst[n][k] = *(const LAS bf16x8*)(lds + PG8_SB(b, h) + boff + n * 2048 + k * 1024); } while (0)
#define PG8_MMA1(ai, bj, At, Bt) do { _Pragma("unroll") for (int m = 0; m < 4; ++m) _Pragma("unroll") for (int n = 0; n < 2; ++n) _Pragma("unroll") for (int k = 0; k < 2; ++k) \
        acc[ai][bj][m][n] = __builtin_amdgcn_mfma_f32_16x16x32_bf16(Bt[n][k], At[m][k], acc[ai][bj][m][n], 0, 0, 0); } while (0)
#define PG8_MMA2(ai, At) do { __builtin_amdgcn_s_setprio(1); PG8_MMA1(ai, 0, At, B0); PG8_MMA1(ai, 1, At, B1); __builtin_amdgcn_s_setprio(0); } while (0)
#define PG8_WAIT_V(n) asm volatile("s_waitcnt vmcnt(" #n ")" ::: "memory")
#define PG8_WAIT_L(n) asm volatile("s_waitcnt lgkmcnt(" #n ")" ::: "memory")
#define PG8_BAR __builtin_amdgcn_s_barrier()
#define PG8_SCHED __builtin_amdgcn_sched_barrier(0)
    Unit cur, nxt; int ui = 0;
    if (!S.next(0, cur)) return;
    LAS float* bxw = (LAS float*)(lds + MISC_OFF + 2048) + wid * 64;
    float b1 = E.pre(cur, wc, lane);
    const __amdgpu_buffer_rsrc_t rsA = __builtin_amdgcn_make_buffer_rsrc((void*)S.A, 0, 0x7fffffff, 0x00020000), rsB = __builtin_amdgcn_make_buffer_rsrc((void*)S.Bt, 0, 0x7fffffff, 0x00020000);
    f32x4 acc[2][2][4][2];
#pragma unroll
    for (int a = 0; a < 2; ++a)
#pragma unroll
        for (int b = 0; b < 2; ++b)
#pragma unroll
            for (int m = 0; m < 4; ++m)
#pragma unroll
                for (int n = 0; n < 2; ++n) acc[a][b][m][n] = (f32x4){0.f, 0.f, 0.f, 0.f};
    bf16x8 At[4][2], B0[2][2], B1[2][2];
    const char* cA = cur.a; const char* cB = cur.b;
    const char* nA = cA;
    if constexpr (Sched::GATHER) { PG8_GIDX(vg, cur); }
    PG8_STAGE(PG8_SB(0, 0), cB, voffB); PG8_STAGE(PG8_SB(0, 1), cB + hstep, voffB); PG8_STAGE_A(PG8_SA(0, 0), 0, 0, false); PG8_STAGE_A(PG8_SA(0, 1), 0, 1, false);
    if (wr == 1) PG8_BAR;
    PG8_WAIT_V(2); PG8_BAR;
    PG8_STAGE(PG8_SB(1, 0), cB + kstep, voffB); PG8_STAGE_A(PG8_SA(1, 0), kstep, 0, false); PG8_STAGE(PG8_SB(1, 1), cB + hstep + kstep, voffB);
    PG8_WAIT_V(6); PG8_BAR;
    for (;;) {
        const bool has_next = S.next(ui + 1, nxt);
        S.prefetch(ui + 2);
        nA = has_next ? nxt.a : cA; const char* nB = has_next ? nxt.b : cB;
#define PG8_KLOOP(LIVE1) do { \
        for (int t = 0; t < nt; t += 2) { \
            const bool last = (t == nt - 2); \
            if constexpr (Sched::GATHER) { if (last) { if (has_next) { PG8_GIDX(nvg, nxt); } else { PG8_GIDX(nvg, cur); } } } \
            const size_t k1 = (size_t)(t + 1) * kstep, k2 = last ? (size_t)0 : (size_t)(t + 2) * kstep, k3 = k2 + kstep; \
            const char* b2 = last ? nB : cB + (size_t)(t + 2) * kstep; const char* b3 = b2 + kstep; \
            PG8_LDB(B0, 0, 0); PG8_LDB(B1, 0, 1); PG8_SCHED; PG8_LDA(At, 0, 0); PG8_STAGE_A(PG8_SA(1, 1), k1, 1, false); \
            PG8_WAIT_V(8); PG8_WAIT_L(0); PG8_BAR; PG8_MMA2(0, At); PG8_BAR; PG8_SCHED; \
            if (LIVE1) { PG8_LDA(At, 0, 1); } PG8_STAGE(PG8_SB(0, 0), b2, voffB); PG8_STAGE(PG8_SB(0, 1), b2 + hstep, voffB); PG8_STAGE_A(PG8_SA(0, 0), k2, 0, last); \
            PG8_WAIT_V(8); PG8_WAIT_L(0); PG8_BAR; if (LIVE1) { PG8_MMA2(1, At); } PG8_BAR; PG8_SCHED; \
            PG8_LDB(B0, 1, 0); PG8_LDB(B1, 1, 1); PG8_SCHED; PG8_LDA(At, 1, 0); PG8_STAGE_A(PG8_SA(0, 1), k2, 1, last); \
            PG8_WAIT_V(8); PG8_WAIT_L(0); PG8_BAR; PG8_MMA2(0, At); PG8_BAR; PG8_SCHED; \
            if (LIVE1) { PG8_LDA(At, 1, 1); } PG8_STAGE(PG8_SB(1, 0), b3, voffB); PG8_STAGE(PG8_SB(1, 1), b3 + hstep, voffB); PG8_STAGE_A(PG8_SA(1, 0), k3, 0, last); \
            PG8_WAIT_V(8); PG8_WAIT_L(0); PG8_BAR; if (LIVE1) { PG8_MMA2(1, At); } PG8_BAR; PG8_SCHED; \
        } } while (0)
        if (cur.vr > HALF) PG8_KLOOP(true); else PG8_KLOOP(false);
        if constexpr (Epi::ALIGN) { if (wr == 0) PG8_BAR; }
        E(acc, cur, wr, wc, fr, fq, b1, bxw);
        if (!has_next) break;
#pragma unroll
        for (int a = 0; a < 2; ++a)
#pragma unroll
            for (int b = 0; b < 2; ++b)
#pragma unroll
                for (int m = 0; m < 4; ++m)
#pragma unroll
                    for (int n = 0; n < 2; ++n) acc[a][b][m][n] = (f32x4){0.f, 0.f, 0.f, 0.f};
        cur = nxt; cA = nA; cB = nB; ++ui;
        b1 = E.pre(cur, wc, lane);
        if constexpr (Sched::GATHER) { PG8_GIDX(vg, cur); }
        if constexpr (Epi::ALIGN) { if (wr == 1) PG8_BAR; }
    }
    if constexpr (!Epi::ALIGN) { if (wr == 0) PG8_BAR; }
    PG8_WAIT_V(0);
    PG8_BAR;
#undef PG8_SA
#undef PG8_SB
#undef PG8_STAGE
#undef PG8_STAGE_R
#undef PG8_STAGE_A
#undef PG8_KLOOP
#undef PG8_GIDX
#undef PG8_LDA
#undef PG8_LDB
#undef PG8_MMA1
#undef PG8_MMA2
#undef PG8_WAIT_V
#undef PG8_WAIT_L
#undef PG8_BAR
#undef PG8_SCHED
}

constexpr float DA_QSCALE = 0.125f * 1.4426950408889634f;
struct EpiProj {
    static constexpr bool PERM = true, ALIGN = true;
    __device__ __forceinline__ float pre(const Unit&, int, int) const { return 0.f; }
    bf16 *sbq, *sbk, *sbv, *daq, *dak, *dav; const float* rope;
    __device__ __forceinline__ void operator()(const f32x4 (&acc)[2][2][4][2], const Unit& u, int wr, int wc, int fr, int fq, float b1, LAS float* bx) const {
        const int ty = u.pn >> 2;
        bf16* base = ty == 0 ? sbq : ty == 1 ? sbk : ty == 2 ? sbv : ty == 3 ? daq : ty == 4 ? dak : dav;
        const bool kv = (ty != 0 && ty != 3);
        const int bb = u.pm >> 4;
        const int rowadd = kv ? 64 * (bb + 1) : 0;
        const int row0 = u.pm * BM + wr * 64 + fr, col0 = (u.pn & 3) * BM + wc * 32 + 8 * fq;
        const bool rope_wave = (ty == 3 || ty == 4) && ((wc & 1) == 0);
        f32x4 rp4[8][4];
#define ROPE_LD(st) do { if (rope_wave) { const int r_ = row0 + ((st) >> 2) * HALF + ((st) & 3) * 16; const float* rp = rope + (size_t)(NMETA + (r_ & (SEQ - 1))) * 16; \
            rp4[st][0] = *(const f32x4*)(rp); rp4[st][1] = *(const f32x4*)(rp + 4); rp4[st][2] = *(const f32x4*)(rp + 8); rp4[st][3] = *(const f32x4*)(rp + 12); } } while (0)
        ROPE_LD(0); ROPE_LD(1);
#pragma unroll
        for (int st = 0; st < 8; ++st) { const int ai = st >> 2, m = st & 3;
                const int r = row0 + ai * HALF + m * 16;
                bf16* rowp = base + (size_t)(r + rowadd) * HW + col0;
                if (st + 2 < 8) ROPE_LD(st + 2);
#pragma unroll
                for (int bj = 0; bj < 2; ++bj) {
                    f32x4 v0 = acc[ai][bj][m][0], v1 = acc[ai][bj][m][1];
                    if (rope_wave) {
                        const f32x4 cs0 = rp4[st][0], cs1 = rp4[st][1], sn0 = rp4[st][2], sn1 = rp4[st][3];
                        f32x4 o0, o1;
#pragma unroll
                        for (int j = 0; j < 4; ++j) { o0[j] = __shfl_xor(v0[j], 16); o1[j] = __shfl_xor(v1[j], 16); }
                        if (fq == 0) { v0 = v0 * cs0 - o0 * sn0; v1 = v1 * cs1 - o1 * sn1; }
                        else if (fq == 1) { v0 = v0 * cs0 + o0 * sn0; v1 = v1 * cs1 + o1 * sn1; }
                    }
                    if (ty == 3) { v0 = v0 * DA_QSCALE; v1 = v1 * DA_QSCALE; }
                    v4u w; w.x = cvt_pk_bf16(v0[0], v0[1]); w.y = cvt_pk_bf16(v0[2], v0[3]); w.z = cvt_pk_bf16(v1[0], v1[1]); w.w = cvt_pk_bf16(v1[2], v1[3]);
                    *(v4u*)(rowp + bj * HALF) = w; } }
#undef ROPE_LD
    }
};
struct EpiRes {
    static constexpr bool PERM = true, ALIGN = true;
    __device__ __forceinline__ float pre(const Unit&, int, int) const { return 0.f; }
    const float* x; bf16* out;
    __device__ __forceinline__ void operator()(const f32x4 (&acc)[2][2][4][2], const Unit& u, int wr, int wc, int fr, int fq, float b1, LAS float* bx) const {
        const int row0 = u.pm * BM + wr * 64 + fr, col0 = u.pn * BM + wc * 32 + 8 * fq;
        f32x4 xs[8][4];
#define RES_LD(st) do { const size_t off_ = (size_t)(row0 + ((st) >> 2) * HALF + ((st) & 3) * 16) * DM + col0; \
            xs[st][0] = *(const f32x4*)(x + off_); xs[st][1] = *(const f32x4*)(x + off_ + 4); xs[st][2] = *(const f32x4*)(x + off_ + HALF); xs[st][3] = *(const f32x4*)(x + off_ + HALF + 4); } while (0)
        RES_LD(0); RES_LD(1); RES_LD(2); RES_LD(3);
#pragma unroll
        for (int st = 0; st < 8; ++st) { const int ai = st >> 2, m = st & 3; const size_t off = (size_t)(row0 + ai * HALF + m * 16) * DM + col0;
            if (st + 4 < 8) RES_LD(st + 4);
#pragma unroll
            for (int bj = 0; bj < 2; ++bj) { const f32x4 v0 = xs[st][2 * bj] + acc[ai][bj][m][0], v1 = xs[st][2 * bj + 1] + acc[ai][bj][m][1];
                v4u w; w.x = cvt_pk_bf16(v0[0], v0[1]); w.y = cvt_pk_bf16(v0[2], v0[3]); w.z = cvt_pk_bf16(v1[0], v1[1]); w.w = cvt_pk_bf16(v1[2], v1[3]);
                *(v4u*)(out + off + bj * HALF) = w; } }
#undef RES_LD
    }
};
struct EpiSwiglu {
    static constexpr bool PERM = true, ALIGN = false;
    __device__ __forceinline__ float pre(const Unit& u, int wc, int lane) const { return bgu[(size_t)u.e * 4096 + u.pn * HALF + wc * 32 + (lane & 31) + (lane >> 5) * 2048]; }
    bf16* act; const float* bgu;
    __device__ __forceinline__ void operator()(const f32x4 (&acc)[2][2][4][2], const Unit& u, int wr, int wc, int fr, int fq, float b1, LAS float* bx) const {
        const int row0 = u.pm * BM + wr * 64 + fr, col0 = u.pn * HALF + wc * 32 + 8 * fq;
        bx[threadIdx.x & 63] = b1;
        const f32x4 g0 = *(const LAS f32x4*)(bx + 8 * fq), g1 = *(const LAS f32x4*)(bx + 8 * fq + 4), u0 = *(const LAS f32x4*)(bx + 32 + 8 * fq), u1 = *(const LAS f32x4*)(bx + 36 + 8 * fq);
#pragma unroll
        for (int ai = 0; ai < 2; ++ai)
#pragma unroll
            for (int m = 0; m < 4; ++m) {
                bf16* rowp = act + (size_t)(row0 + ai * HALF + m * 16) * DM + col0;
                float o[8];
#pragma unroll
                for (int n = 0; n < 2; ++n)
#pragma unroll
                    for (int j = 0; j < 4; j += 2) {
                        const f32x4 gb = n ? g1 : g0, ub = n ? u1 : u0;
                        const f32x2_t hg = f32x2_t{acc[ai][0][m][n][j], acc[ai][0][m][n][j + 1]} + f32x2_t{gb[j], gb[j + 1]};
                        const f32x2_t hu = f32x2_t{acc[ai][1][m][n][j], acc[ai][1][m][n][j + 1]} + f32x2_t{ub[j], ub[j + 1]};
                        const f32x2_t gt = {fminf(hg[0], 7.0f), fminf(hg[1], 7.0f)}, up = {fminf(fmaxf(hu[0], -7.0f), 7.0f), fminf(fmaxf(hu[1], -7.0f), 7.0f)};
                        const f32x2_t t = gt * (-1.702f * 1.4426950408889634f);
                        const f32x2_t dn = f32x2_t{__builtin_amdgcn_exp2f(t[0]), __builtin_amdgcn_exp2f(t[1])} + 1.0f;
                        const f32x2_t sg = {__builtin_amdgcn_rcpf(dn[0]), __builtin_amdgcn_rcpf(dn[1])};
                        const f32x2_t r2 = (up * gt + gt) * sg;
                        o[n * 4 + j] = r2[0]; o[n * 4 + j + 1] = r2[1]; }
                v4u w; w.x = cvt_pk_bf16(o[0], o[1]); w.y = cvt_pk_bf16(o[2], o[3]); w.z = cvt_pk_bf16(o[4], o[5]); w.w = cvt_pk_bf16(o[6], o[7]);
                *(v4u*)rowp = w; }
    }
};
struct EpiDown {
    static constexpr bool PERM = true, ALIGN = true;
    __device__ __forceinline__ float pre(const Unit& u, int wc, int lane) const { return bdn[(size_t)u.e * DM + u.pn * BM + wc * 32 + (lane & 31) + (lane >> 5) * HALF]; }
    bf16* ys; const float* bdn;
    __device__ __forceinline__ void operator()(const f32x4 (&acc)[2][2][4][2], const Unit& u, int wr, int wc, int fr, int fq, float b1, LAS float* bx) const {
        const int row0 = u.pm * BM + wr * 64 + fr, col0 = u.pn * BM + wc * 32 + 8 * fq;
        bx[threadIdx.x & 63] = b1;
        f32x4 bv[2][2];
#pragma unroll
        for (int bj = 0; bj < 2; ++bj)
#pragma unroll
            for (int n = 0; n < 2; ++n) bv[bj][n] = *(const LAS f32x4*)(bx + bj * 32 + 8 * fq + 4 * n);
#pragma unroll
        for (int ai = 0; ai < 2; ++ai)
#pragma unroll
            for (int m = 0; m < 4; ++m) { bf16* rowp = ys + (size_t)(row0 + ai * HALF + m * 16) * DM + col0;
#pragma unroll
                for (int bj = 0; bj < 2; ++bj) { const f32x4 v0 = acc[ai][bj][m][0] + bv[bj][0], v1 = acc[ai][bj][m][1] + bv[bj][1];
                    v4u w; w.x = cvt_pk_bf16(v0[0], v0[1]); w.y = cvt_pk_bf16(v0[2], v0[3]); w.z = cvt_pk_bf16(v1[0], v1[1]); w.w = cvt_pk_bf16(v1[2], v1[3]);
                    *(v4u*)(rowp + bj * HALF) = w; } }
    }
};
}

struct Args { const float* in[19]; float* out; unsigned char* ws; int ph_lo, ph_hi; };
enum { I_X = 0, I_META, I_GMIX, I_WIN, I_LQ1, I_LK1, I_LQ2, I_LK2, I_GSB, I_GDA, I_WOUT, I_GFFN, I_WR, I_BR, I_WGU, I_BGU, I_WDN, I_BDN, I_GFIN };
constexpr int NWAVES = 8;

struct TrItem { const float* src; bf16* dst; int N; };
__device__ __forceinline__ TrItem tr_decode(const Args& a, int it) {
    unsigned char* ws = a.ws;
    constexpr int T_IN = 32 * (INCOLS / 64), T_OUT = 32 * (DM / 64), T_GU1 = 32 * (4096 / 64), T_DN1 = 32 * (DM / 64);
    TrItem t; int r = it;
    if (r < T_IN) { const int kb = r & 31, nb = r >> 5; t.N = INCOLS; t.src = a.in[I_WIN] + (size_t)(64 * kb) * INCOLS + 64 * nb; t.dst = (bf16*)(ws + WS_WIN) + (size_t)(64 * nb) * DM + 64 * kb; return t; } r -= T_IN;
    if (r < T_OUT) { const int kb = r & 31, nb = r >> 5; t.N = DM; t.src = a.in[I_WOUT] + (size_t)(64 * kb) * DM + 64 * nb; t.dst = (bf16*)(ws + WS_WOUT) + (size_t)(64 * nb) * DM + 64 * kb; return t; } r -= T_OUT;
    if (r < NEXP * T_GU1) { const int e = r / T_GU1, q = r % T_GU1, kb = q & 31, nb = q >> 5, n0 = 64 * nb;
        const int drow0 = n0 < 2048 ? (n0 >> 7) * 256 + (n0 & 127) : ((n0 - 2048) >> 7) * 256 + 128 + ((n0 - 2048) & 127);
        t.N = 4096; t.src = a.in[I_WGU] + (size_t)e * DM * 4096 + (size_t)(64 * kb) * 4096 + n0; t.dst = (bf16*)(ws + WS_WGU) + (size_t)e * 4096 * DM + (size_t)drow0 * DM + 64 * kb; return t; } r -= NEXP * T_GU1;
    { const int e = r / T_DN1, q = r % T_DN1, kb = q & 31, nb = q >> 5;
        t.N = DM; t.src = a.in[I_WDN] + (size_t)e * DM * DM + (size_t)(64 * kb) * DM + 64 * nb; t.dst = (bf16*)(ws + WS_WDN) + (size_t)e * DM * DM + (size_t)(64 * nb) * DM + 64 * kb; return t; }
}
constexpr int TR_NITEMS = 32 * (INCOLS / 64) + 32 * (DM / 64) + NEXP * 32 * (4096 / 64) + NEXP * 32 * (DM / 64);
__device__ __forceinline__ void tr_load(const TrItem& t, f32x4 (&ra)[8], f32x4 (&rb)[8], int lane) {
    const int q = lane >> 4, n4 = lane & 15;
    const float* p = t.src + (size_t)(2 * q) * t.N + 4 * n4;
#pragma unroll
    for (int i = 0; i < 8; ++i) { ra[i] = __builtin_nontemporal_load((const f32x4*)(p + (size_t)(8 * i) * t.N)); rb[i] = __builtin_nontemporal_load((const f32x4*)(p + (size_t)(8 * i + 1) * t.N)); }
}
__device__ __forceinline__ void tr_store(const TrItem& t, const f32x4 (&ra)[8], const f32x4 (&rb)[8], LAS unsigned* scr, int lane) {
    const int q = lane >> 4, n4 = lane & 15;
#pragma unroll
    for (int i = 0; i < 8; ++i)
#pragma unroll
        for (int j = 0; j < 4; ++j) scr[(4 * n4 + j) * 32 + ((i ^ (n4 & 7)) << 2) + q] = cvt2bf(ra[i][j], rb[i][j]);
    LDS_WAIT(); asm volatile("" ::: "memory");
    const int nr = lane >> 3, ch = lane & 7;
#pragma unroll
    for (int i = 0; i < 8; ++i) { const int n = nr + 8 * i; const v4u v = *(const LAS v4u*)(scr + n * 32 + ((ch ^ ((n >> 2) & 7)) << 2));
        __builtin_nontemporal_store(v, (v4u*)(t.dst + (size_t)n * DM + 8 * ch)); }
    LDS_WAIT(); asm volatile("" ::: "memory");
}
constexpr int TR_SMALL = 32 * (INCOLS / 64) + 32 * (DM / 64);
__device__ __forceinline__ void conv_items(const Args& a, LAS unsigned char* lds, int it0, int it1, int vcu, int G, int lane, int wave) {
    LAS unsigned* scr = (LAS unsigned*)(lds + wave * 16384);
    const int gw = vcu * NWAVES + wave, NGW = G * NWAVES;
    f32x4 ra[8], rb[8], na[8], nb_[8];
    int it = it0 + gw;
    if (it >= it1) return;
    TrItem cur = tr_decode(a, it);
    tr_load(cur, ra, rb, lane);
    for (;;) {
        int nx = it + NGW; bool has = nx < it1;
        TrItem nxt = tr_decode(a, has ? nx : it);
        if (has) tr_load(nxt, na, nb_, lane);
        tr_store(cur, ra, rb, scr, lane);
        if (!has) break;
        it = nx; nx = it + NGW; has = nx < it1;
        cur = tr_decode(a, has ? nx : it);
        if (has) tr_load(cur, ra, rb, lane);
        tr_store(nxt, na, nb_, scr, lane);
        if (!has) break;
        it = nx;
    }
}
constexpr int TR_GU_END = TR_SMALL + NEXP * 32 * (4096 / 64);
constexpr int TR_S1 = TR_SMALL + (TR_GU_END - TR_SMALL) * 45 / 100, TR_S2 = TR_SMALL + (TR_GU_END - TR_SMALL) * 85 / 100;
__device__ __forceinline__ void conv_slice(const Args& a, LAS unsigned char* lds, int which, int vcu, int G, int lane, int wave) {
    const int it0 = which == 0 ? TR_SMALL : which == 1 ? TR_S1 : which == 2 ? TR_S2 : TR_GU_END, it1 = which == 0 ? TR_S1 : which == 1 ? TR_S2 : which == 2 ? TR_GU_END : TR_NITEMS;
    conv_items(a, lds, it0, it1, vcu, G, lane, wave);
    __syncthreads();
}
__device__ __forceinline__ void rms_row_to_bf16(const float* xrow, const float* g, bf16* orow, int lane) {
    const f32x4* xr = (const f32x4*)xrow + lane; const f32x4* gr = (const f32x4*)g + lane;
    f32x4 v[8]; float s = 0.f;
#pragma unroll
    for (int j = 0; j < 8; ++j) { v[j] = xr[64 * j]; s += (v[j].x * v[j].x + v[j].y * v[j].y) + (v[j].z * v[j].z + v[j].w * v[j].w); }
    const float rstd = 1.0f / sqrtf(wave_sum(s) * (1.f / DM) + RMS_EPS);
    v2u* o8 = (v2u*)orow + lane;
#pragma unroll
    for (int j = 0; j < 8; ++j) { const f32x4 gg = gr[64 * j]; v2u w; w.x = pk2(v[j].x * rstd * gg.x, v[j].y * rstd * gg.y); w.y = pk2(v[j].z * rstd * gg.z, v[j].w * rstd * gg.w); o8[64 * j] = w; }
}
__device__ __forceinline__ void sincos_rev(double t, float& s, float& c) {
    t -= __builtin_rint(t);
    const double x = t * 6.283185307179586476925286766559, x2 = x * x;
    double ts = x, ss = x, tc = 1.0, cc = 1.0;
#pragma unroll
    for (int k = 1; k <= 14; ++k) { ts *= -x2 / (double)((2 * k) * (2 * k + 1)); ss += ts; tc *= -x2 / (double)((2 * k - 1) * (2 * k)); cc += tc; }
    s = (float)ss; c = (float)cc;
}

__device__ __forceinline__ float rope_inv_freq(int j) {
    return j == 0 ? 1.0f : j == 1 ? 0.1939227432012558f : j == 2 ? 0.03760603070259094f : j == 3 ? 0.007292664609849453f : j == 4 ? 0.0014142135623842478f : j == 5 ? 0.00027424818836152554f : j == 6 ? 5.318296098266728e-05f : 1.0313386155758053e-05f;
}
__device__ __forceinline__ void phase0(const Args& a, LAS unsigned char* lds, int vcu, int G, int tid, int lane, int wave) {
    unsigned char* ws = a.ws;
    for (int unit = vcu; unit < 256; unit += G) {
        LAS float* um = (LAS float*)lds;
        for (int rr = 0; rr < 2; ++rr) { const int r = wave * 2 + rr;
            const f32x4* xr = (const f32x4*)(a.in[I_META] + (size_t)r * DM) + lane; const f32x4* gr = (const f32x4*)a.in[I_GMIX] + lane;
            f32x4 v[8]; float s = 0.f;
#pragma unroll
            for (int j = 0; j < 8; ++j) { v[j] = xr[64 * j]; s += (v[j].x * v[j].x + v[j].y * v[j].y) + (v[j].z * v[j].z + v[j].w * v[j].w); }
            const float rstd = 1.0f / sqrtf(wave_sum(s) * (1.f / DM) + RMS_EPS);
#pragma unroll
            for (int j = 0; j < 8; ++j) { const f32x4 gg = gr[64 * j]; *(LAS f32x4*)(um + r * DM + 4 * (lane + 64 * j)) = v[j] * rstd * gg; } }
        __syncthreads();
        const int grp = unit >> 6, cbase = (unit & 63) * 16;
        const int cl = tid & 15, ks = tid >> 4;
        const int scol = (grp == 0 ? 1024 : grp == 1 ? 2048 : grp == 2 ? 4096 : 5120) + cbase + cl;
        float acc[16];
#pragma unroll
        for (int r = 0; r < 16; ++r) acc[r] = 0.f;
        const float* wp = a.in[I_WIN] + (size_t)(ks * 64) * INCOLS + scol;
#pragma unroll 1
        for (int kb = 0; kb < 8; ++kb) { float w[8];
#pragma unroll
            for (int q = 0; q < 8; ++q) w[q] = wp[(size_t)(kb * 8 + q) * INCOLS];
#pragma unroll
            for (int q4 = 0; q4 < 2; ++q4)
#pragma unroll
                for (int r = 0; r < 16; ++r) { const f32x4 u = *(const LAS f32x4*)(um + r * DM + ks * 64 + kb * 8 + 4 * q4);
                    acc[r] += (u.x * w[4 * q4] + u.y * w[4 * q4 + 1]) + (u.z * w[4 * q4 + 2] + u.w * w[4 * q4 + 3]); } }
        __syncthreads();
        LAS float* red = (LAS float*)lds;
#pragma unroll
        for (int r = 0; r < 16; ++r) red[(ks * 16 + r) * 16 + cl] = acc[r];
        __syncthreads();
        LAS float* res = red + 32 * 16 * 16;
        if (tid < 256) { float sm = 0.f;
#pragma unroll
            for (int q = 0; q < 32; ++q) sm += red[(q * 16 + (tid >> 4)) * 16 + (tid & 15)];
            res[tid] = sm; }
        __syncthreads();
        bf16* dst = (bf16*)(ws + (grp == 0 ? WS_SBK : grp == 1 ? WS_SBV : grp == 2 ? WS_DAK : WS_DAV));
        if (tid < 256) { const int r = tid >> 4, c = tid & 15; float v = res[tid];
            if (grp == 2) { const int d = (cbase + c) & 63;
                if (d < 16) { float sn, cs; { const float ang = (float)r * rope_inv_freq(d & 7); sincos_rev((double)ang * 0.15915494309189533576888376337251, sn, cs); }
                    const float other = res[r * 16 + (c ^ 8)];
                    v = (d < 8) ? v * cs - other * sn : v * cs + other * sn; } }
            const unsigned short bv = (unsigned short)f2bf(v);
#pragma unroll
            for (int b = 0; b < BATCH; ++b) dst[(size_t)(b * LPB + KVPAD + r) * HW + cbase + c] = bv; }
        __syncthreads();
    }
    { const int gt = vcu * 512 + tid, NT = G * 512;
      for (int i = gt; i < 4 * BATCH * KVPAD * (HW / 8); i += NT) { const int t = i / (BATCH * KVPAD * (HW / 8)), rem = i % (BATCH * KVPAD * (HW / 8)), b = rem / (KVPAD * (HW / 8)), rr = (rem / (HW / 8)) % KVPAD, c8 = rem % (HW / 8);
          bf16* dst = (bf16*)(ws + (t == 0 ? WS_SBK : t == 1 ? WS_SBV : t == 2 ? WS_DAK : WS_DAV));
          *(v4u*)(dst + (size_t)(b * LPB + rr) * HW + c8 * 8) = (v4u){0u, 0u, 0u, 0u}; }
      float* rope = (float*)(ws + WS_ROPE);
      for (int i = gt; i < (NMETA + SEQ) * 8; i += NT) { const int pos = i >> 3, j = i & 7;
          const float ang = (float)pos * rope_inv_freq(j); float sn, cs; sincos_rev((double)ang * 0.15915494309189533576888376337251, sn, cs);
          rope[pos * 16 + j] = cs; rope[pos * 16 + 8 + j] = sn; }
      { float* wgt = (float*)(ws + WS_WG); for (int i = gt; i < DM * NEXP; i += NT) wgt[i] = a.in[I_GFFN][i >> 5] * a.in[I_WR][i]; }
      if (vcu == 0 && wave == 0) { const float d1 = wave_sum(a.in[I_LQ1][lane] * a.in[I_LK1][lane]), d2 = wave_sum(a.in[I_LQ2][lane] * a.in[I_LK2][lane]);
          if (lane == 0) ((float*)(ws + WS_CTL))[CW_LAM] = expf(d1) - expf(d2) + LAM_INIT; } }
    conv_items(a, lds, 0, TR_SMALL, vcu, G, lane, wave);
    { const int gw = vcu * NWAVES + wave, NGW = G * NWAVES;
      f32x4 gg[8], cur[8];
      { const f32x4* gr = (const f32x4*)a.in[I_GMIX] + lane;
#pragma unroll
        for (int j = 0; j < 8; ++j) gg[j] = gr[64 * j]; }
      { const f32x4* xr = (const f32x4*)(a.in[I_X] + (size_t)(gw < NTOK ? gw : NTOK - 1) * DM) + lane;
#pragma unroll
        for (int j = 0; j < 8; ++j) cur[j] = xr[64 * j]; }
      for (int m = gw; m < NTOK; m += NGW) {
          f32x4 nxt[8];
          { const int mn = m + NGW < NTOK ? m + NGW : NTOK - 1; const f32x4* xr = (const f32x4*)(a.in[I_X] + (size_t)mn * DM) + lane;
#pragma unroll
            for (int j = 0; j < 8; ++j) nxt[j] = xr[64 * j]; }
          float sq = 0.f;
#pragma unroll
          for (int j = 0; j < 8; ++j) sq += (cur[j].x * cur[j].x + cur[j].y * cur[j].y) + (cur[j].z * cur[j].z + cur[j].w * cur[j].w);
          const float rstd = __builtin_amdgcn_rsqf(wave_sum(sq) * (1.f / DM) + RMS_EPS);
          v2u* o8 = (v2u*)((bf16*)(ws + WS_U) + (size_t)m * DM) + lane;
#pragma unroll
          for (int j = 0; j < 8; ++j) { const f32x4 uu = cur[j] * rstd * gg[j]; v2u w; w.x = cvt2bf(uu.x, uu.y); w.y = cvt2bf(uu.z, uu.w); o8[64 * j] = w; }
#pragma unroll
          for (int j = 0; j < 8; ++j) cur[j] = nxt[j];
      }
    }
}

__device__ __forceinline__ void phase4(const Args& a, LAS unsigned char* lds, int vcu, int G, int tid, int lane, int wave) {
    unsigned char* ws = a.ws;
    LAS float* xs = (LAS float*)lds;
    LAS float* red = (LAS float*)(lds + 66048);
    LAS float* lg = (LAS float*)(lds + 99840);
    LAS float* rsd = (LAS float*)(lds + 104064);
    LAS unsigned* cl = (LAS unsigned*)(lds + 104192);
    LAS int* sel_e = (LAS int*)(lds + 104448); LAS int* sel_r = sel_e + 128; LAS float* sel_g = (LAS float*)(sel_r + 128);
    int* r_e = (int*)(ws + WS_ROUTE); float* r_g = (float*)(ws + WS_ROUTE + 256 * 1024); int* r_rank = (int*)(ws + WS_ROUTE + 512 * 1024);
    int* elist = (int*)(ws + WS_ELIST);
    unsigned* cnt = (unsigned*)(ws + WS_CTL) + CW_CNT;
    const float* wg = (const float*)(ws + WS_WG);
    const int r32 = lane & 31, hi = lane >> 5;
    f32x4 gff[8];
    { const f32x4* gr = (const f32x4*)a.in[I_GFFN] + lane;
#pragma unroll
      for (int j = 0; j < 8; ++j) gff[j] = gr[64 * j]; }
    for (int grp = vcu; grp < NTOK / 32; grp += G) {
        const int tok0 = grp * 32;
        f32x4 v[4][8]; float rs4[4];
#pragma unroll
        for (int rr = 0; rr < 4; ++rr) { const int m = tok0 + 4 * wave + rr;
            const v2u* xr = (const v2u*)((const bf16*)(ws + WS_U) + (size_t)m * DM) + lane;
            float s = 0.f;
#pragma unroll
            for (int j = 0; j < 8; ++j) { const v2u hw = xr[64 * j]; v[rr][j] = (f32x4){bflo(hw.x), bfhi(hw.x), bflo(hw.y), bfhi(hw.y)}; s += (v[rr][j].x * v[rr][j].x + v[rr][j].y * v[rr][j].y) + (v[rr][j].z * v[rr][j].z + v[rr][j].w * v[rr][j].w); }
            rs4[rr] = 1.0f / sqrtf(wave_sum(s) * (1.f / DM) + RMS_EPS); }
#pragma unroll
        for (int rr = 0; rr < 4; ++rr) { const int m = tok0 + 4 * wave + rr; const float rstd = rs4[rr];
            v2u* o8 = (v2u*)((bf16*)(ws + WS_U2) + (size_t)m * DM) + lane;
#pragma unroll
            for (int j = 0; j < 8; ++j) { const f32x4 uu = v[rr][j] * rstd * gff[j]; v2u w; w.x = cvt2bf(uu.x, uu.y); w.y = cvt2bf(uu.z, uu.w); o8[64 * j] = w; }
            if (lane == 0) rsd[4 * wave + rr] = rstd; }
        if (tid < 32) cl[tid] = 0u;
        f32x16 acc;
#pragma unroll
        for (int r = 0; r < 16; ++r) acc[r] = 0.f;
#pragma unroll
        for (int sl = 0; sl < 4; ++sl) {
#pragma unroll
            for (int rr = 0; rr < 4; ++rr)
#pragma unroll
                for (int jj = 0; jj < 2; ++jj) *(LAS f32x4*)(xs + (4 * wave + rr) * 516 + 4 * lane + 256 * jj) = v[rr][2 * sl + jj];
            __syncthreads();
            const float* wp = wg + (size_t)(512 * sl + 64 * wave + hi) * NEXP + r32;
            const LAS float* xp = xs + r32 * 516 + 64 * wave + hi;
#pragma unroll 8
            for (int st = 0; st < 32; ++st) acc = __builtin_amdgcn_mfma_f32_32x32x2f32(wp[st * 2 * NEXP], xp[2 * st], acc, 0, 0, 0);
            __syncthreads();
        }
#pragma unroll
        for (int r = 0; r < 16; ++r) red[(wave * 32 + r32) * 33 + ((r & 3) + 8 * (r >> 2) + 4 * hi)] = acc[r];
        __syncthreads();
        { const int tk = tid >> 4, e0 = (tid & 15) * 2;
#pragma unroll
          for (int q = 0; q < 2; ++q) { float sm = 0.f;
#pragma unroll
              for (int w8 = 0; w8 < 8; ++w8) sm += red[(w8 * 32 + tk) * 33 + e0 + q];
              lg[tk * 33 + e0 + q] = sm * rsd[tk] + a.in[I_BR][e0 + q]; } }
        __syncthreads();
        if (tid < 32) {
            unsigned taken = 0u; float sv[4]; int si[4];
#pragma unroll
            for (int r = 0; r < 4; ++r) { float bv = -3.0e38f; int bi = 0;
                for (int e = 0; e < NEXP; ++e) { const float x = lg[tid * 33 + e]; if (!((taken >> e) & 1u) && x > bv) { bv = x; bi = e; } }
                sv[r] = bv; si[r] = bi; taken |= 1u << bi; }
            const float e1 = __expf(sv[1] - sv[0]), e2 = __expf(sv[2] - sv[0]), e3 = __expf(sv[3] - sv[0]), inv = 1.0f / (1.0f + e1 + e2 + e3);
#pragma unroll
            for (int r = 0; r < 4; ++r) { sel_e[tid * 4 + r] = si[r]; sel_g[tid * 4 + r] = (r == 0 ? 1.0f : r == 1 ? e1 : r == 2 ? e2 : e3) * inv;
                sel_r[tid * 4 + r] = (int)__hip_atomic_fetch_add(cl + si[r], 1u, __ATOMIC_RELAXED, __HIP_MEMORY_SCOPE_WORKGROUP); }
        }
        __syncthreads();
        if (tid < 32) { const unsigned c = cl[tid]; cl[32 + tid] = c ? __hip_atomic_fetch_add(cnt + 64 * tid, c, __ATOMIC_RELAXED, __HIP_MEMORY_SCOPE_AGENT) : 0u; }
        __syncthreads();
        if (tid < 128) { const int e = sel_e[tid], rank = (int)cl[32 + e] + sel_r[tid], tok = tok0 + (tid >> 2);
            r_e[tok * 4 + (tid & 3)] = e; r_g[tok * 4 + (tid & 3)] = sel_g[tid]; r_rank[tok * 4 + (tid & 3)] = rank; elist[(size_t)e * NTOK + rank] = tok; }
        __syncthreads();
    }
}
__device__ __forceinline__ int moe_build_tiles(const Args& a, LAS unsigned char* lds, int tid) {
    unsigned* ctl = (unsigned*)(a.ws + WS_CTL);
    LAS int* tp = (LAS int*)(lds + MISC_OFF + 1024); LAS int* te = (LAS int*)(lds + TE_OFF); LAS unsigned* cn = (LAS unsigned*)(lds + CNT_OFF);
    if (tid < NEXP) cn[tid] = __hip_atomic_load(ctl + CW_CNT + 64 * tid, __ATOMIC_RELAXED, __HIP_MEMORY_SCOPE_AGENT);
    __syncthreads();
    if (tid == 0) { int s = 0; for (int e = 0; e < NEXP; ++e) { tp[e] = s; s += (int)((cn[e] + 255u) >> 8); } tp[NEXP] = s; }
    __syncthreads();
    for (int e = 0; e < NEXP; ++e) { const int lo = tp[e], hi = tp[e + 1]; for (int t = lo + tid; t < hi; t += 512) te[t] = e; }
    __syncthreads();
    return tp[NEXP];
}
__device__ __forceinline__ void phase7(const Args& a, LAS unsigned char* lds, int vcu, int G, int tid, int lane, int wave) {
    unsigned char* ws = a.ws;
    unsigned* ctl = (unsigned*)(ws + WS_CTL);
    LAS int* tp = (LAS int*)(lds + MISC_OFF + 1024);
    { LAS unsigned* cn = (LAS unsigned*)(lds + CNT_OFF);
      if (tid < NEXP) cn[tid] = __hip_atomic_load(ctl + CW_CNT + 64 * tid, __ATOMIC_RELAXED, __HIP_MEMORY_SCOPE_AGENT);
      __syncthreads();
      if (tid == 0) { int s = 0; for (int e = 0; e < NEXP; ++e) { tp[e] = s; s += (int)((cn[e] + 255u) >> 8); } tp[NEXP] = s; } }
    __syncthreads();
    const int gw = vcu * NWAVES + wave, NGW = G * NWAVES;
    const int* r_e = (const int*)(ws + WS_ROUTE); const float* r_g = (const float*)(ws + WS_ROUTE + 256 * 1024); const int* r_rank = (const int*)(ws + WS_ROUTE + 512 * 1024);
    f32x4 gfin[8];
    { const f32x4* gr = (const f32x4*)a.in[I_GFIN] + 2 * lane;
#pragma unroll
      for (int j = 0; j < 4; ++j) { gfin[2 * j] = gr[128 * j]; gfin[2 * j + 1] = gr[128 * j + 1]; } }
    int e_c[4], rk_c[4]; float g_c[4]; v4u h_c[4];
    { const int t0 = gw < NTOK ? gw : NTOK - 1; const v4u* hr = (const v4u*)((const bf16*)(ws + WS_U) + (size_t)t0 * DM) + lane;
#pragma unroll
      for (int r = 0; r < 4; ++r) { e_c[r] = r_e[t0 * 4 + r]; rk_c[r] = r_rank[t0 * 4 + r]; g_c[r] = r_g[t0 * 4 + r]; }
#pragma unroll
      for (int j = 0; j < 4; ++j) h_c[j] = hr[64 * j]; }
    for (int tok = gw; tok < NTOK; tok += NGW) {
        v4u y[4][4];
#pragma unroll
        for (int r = 0; r < 4; ++r) { const size_t pos = (size_t)tp[e_c[r]] * 256 + rk_c[r]; const v4u* yr = (const v4u*)((const bf16*)(ws + WS_YS) + pos * DM) + lane;
#pragma unroll
            for (int j = 0; j < 4; ++j) y[r][j] = yr[64 * j]; }
        int e_n[4], rk_n[4]; float g_n[4]; v4u h_n[4];
        { const int tn = tok + NGW < NTOK ? tok + NGW : NTOK - 1; const v4u* hr = (const v4u*)((const bf16*)(ws + WS_U) + (size_t)tn * DM) + lane;
#pragma unroll
          for (int r = 0; r < 4; ++r) { e_n[r] = r_e[tn * 4 + r]; rk_n[r] = r_rank[tn * 4 + r]; g_n[r] = r_g[tn * 4 + r]; }
#pragma unroll
          for (int j = 0; j < 4; ++j) h_n[j] = hr[64 * j]; }
        float v[4][8];
#pragma unroll
        for (int j = 0; j < 4; ++j) { const v4u hw = h_c[j];
            v[j][0] = bflo(hw.x); v[j][1] = bfhi(hw.x); v[j][2] = bflo(hw.y); v[j][3] = bfhi(hw.y); v[j][4] = bflo(hw.z); v[j][5] = bfhi(hw.z); v[j][6] = bflo(hw.w); v[j][7] = bfhi(hw.w); }
#pragma unroll
        for (int r = 0; r < 4; ++r) { const float gte = g_c[r];
#pragma unroll
            for (int j = 0; j < 4; ++j) { const v4u w = y[r][j];
                v[j][0] += gte * bflo(w.x); v[j][1] += gte * bfhi(w.x); v[j][2] += gte * bflo(w.y); v[j][3] += gte * bfhi(w.y);
                v[j][4] += gte * bflo(w.z); v[j][5] += gte * bfhi(w.z); v[j][6] += gte * bflo(w.w); v[j][7] += gte * bfhi(w.w); } }
#pragma unroll
        for (int r = 0; r < 4; ++r) { e_c[r] = e_n[r]; rk_c[r] = rk_n[r]; g_c[r] = g_n[r]; h_c[r] = h_n[r]; }
        float s = 0.f;
#pragma unroll
        for (int j = 0; j < 4; ++j)
#pragma unroll
            for (int q = 0; q < 8; ++q) s += v[j][q] * v[j][q];
        const float rstd = 1.0f / sqrtf(wave_sum(s) * (1.f / DM) + RMS_EPS);
        f32x4* xr = (f32x4*)(a.out + (size_t)tok * DM) + 2 * lane;
#pragma unroll
        for (int j = 0; j < 4; ++j) { const f32x4 g0 = gfin[2 * j], g1 = gfin[2 * j + 1];
            xr[128 * j] = (f32x4){v[j][0] * rstd * g0.x, v[j][1] * rstd * g0.y, v[j][2] * rstd * g0.z, v[j][3] * rstd * g0.w};
            xr[128 * j + 1] = (f32x4){v[j][4] * rstd * g1.x, v[j][5] * rstd * g1.y, v[j][6] * rstd * g1.z, v[j][7] * rstd * g1.w}; }
    }
}
namespace att {
using s16x4 = __attribute__((ext_vector_type(4))) short;
#define KSWZ(row, colB) ((row) * 256 + ((colB) ^ (((row) & 7) << 4)))
#define SBAR() __builtin_amdgcn_sched_barrier(0)
__device__ __forceinline__ int crow(int r, int hi) { return (r & 3) + 8 * (r >> 2) + 4 * hi; }
__device__ __forceinline__ unsigned cvtpk(float lo, float hi) { return cvt2bf(lo, hi); }
__device__ __forceinline__ int v_st(int k, int c) { const int kk = (k & ~0xC) | ((k & 4) << 1) | ((k & 8) >> 1); return ((kk >> 3) * 4 + (c >> 5)) * 512 + ((kk & 7) * 32 + (c & 31)) * 2; }
__device__ __forceinline__ int v_rd_base(int lane) { return ((lane & 3) << 3) | (((lane >> 2) & 3) << 6) | (((lane >> 4) & 1) << 5) | (((lane >> 5) & 1) << 8); }
constexpr int v_rd_off(int d0, int ks, int half) { return d0 * 512 + ks * 4096 + half * 2048; }
template <int OFF> __device__ __forceinline__ s16x4 tr_read(int vb) { s16x4 r; asm volatile("ds_read_b64_tr_b16 %0, %1 offset:%2" : "=&v"(r) : "v"(vb), "i"(OFF) : "memory"); return r; }
#define ATT_RDK(X, KS) do { X##0 = tr_read<v_rd_off(0, KS, 0)>(vb); X##1 = tr_read<v_rd_off(0, KS, 1)>(vb); X##2 = tr_read<v_rd_off(1, KS, 0)>(vb); X##3 = tr_read<v_rd_off(1, KS, 1)>(vb); \
    X##4 = tr_read<v_rd_off(2, KS, 0)>(vb); X##5 = tr_read<v_rd_off(2, KS, 1)>(vb); X##6 = tr_read<v_rd_off(3, KS, 0)>(vb); X##7 = tr_read<v_rd_off(3, KS, 1)>(vb); } while (0)
#define ATT_PKV(L, H) (bf16x8){L[0], L[1], L[2], L[3], H[0], H[1], H[2], H[3]}
#define ATT_MMAK(PA, X) do { o[0] = __builtin_amdgcn_mfma_f32_32x32x16_bf16(PA, ATT_PKV(X##0, X##1), o[0], 0, 0, 0); o[1] = __builtin_amdgcn_mfma_f32_32x32x16_bf16(PA, ATT_PKV(X##2, X##3), o[1], 0, 0, 0); \
    o[2] = __builtin_amdgcn_mfma_f32_32x32x16_bf16(PA, ATT_PKV(X##4, X##5), o[2], 0, 0, 0); o[3] = __builtin_amdgcn_mfma_f32_32x32x16_bf16(PA, ATT_PKV(X##6, X##7), o[3], 0, 0, 0); } while (0)
__device__ __forceinline__ void pv_pipe(f32x16* o, int vb, bf16x8 pa0, bf16x8 pa1, bf16x8 pa2, bf16x8 pa3) {
    s16x4 a0, a1, a2, a3, a4, a5, a6, a7, b0, b1, b2, b3, b4, b5, b6, b7;
    SBAR(); ATT_RDK(a, 0); ATT_RDK(b, 1);
    asm volatile("s_waitcnt lgkmcnt(8)" ::: "memory"); SBAR(); ATT_MMAK(pa0, a);
    SBAR(); ATT_RDK(a, 2);
    asm volatile("s_waitcnt lgkmcnt(8)" ::: "memory"); SBAR(); ATT_MMAK(pa1, b);
    SBAR(); ATT_RDK(b, 3);
    asm volatile("s_waitcnt lgkmcnt(8)" ::: "memory"); SBAR(); ATT_MMAK(pa2, a);
    asm volatile("s_waitcnt lgkmcnt(0)" ::: "memory"); SBAR(); ATT_MMAK(pa3, b);
}
template <int BLK> __device__ __forceinline__ void pv_half(f32x16* o, int vb, bf16x8 paA, bf16x8 paB) {
    s16x4 a0, a1, a2, a3, a4, a5, a6, a7, b0, b1, b2, b3, b4, b5, b6, b7;
    SBAR(); ATT_RDK(a, 2 * BLK); ATT_RDK(b, 2 * BLK + 1);
    asm volatile("s_waitcnt lgkmcnt(8)" ::: "memory"); SBAR(); ATT_MMAK(paA, a);
    asm volatile("s_waitcnt lgkmcnt(0)" ::: "memory"); SBAR(); ATT_MMAK(paB, b);
}
#define ATT_PK4(P, BASE, OUT) do { unsigned a0_ = cvtpk(P[BASE + 0], P[BASE + 1]), a1_ = cvtpk(P[BASE + 2], P[BASE + 3]);   \
    unsigned b0_ = cvtpk(P[BASE + 4], P[BASE + 5]), b1_ = cvtpk(P[BASE + 6], P[BASE + 7]);                              \
    auto r0_ = __builtin_amdgcn_permlane32_swap(a0_, b0_, false, false); auto r1_ = __builtin_amdgcn_permlane32_swap(a1_, b1_, false, false); \
    v4u w_ = {r0_[0], r1_[0], r0_[1], r1_[1]}; OUT = *reinterpret_cast<bf16x8*>(&w_); } while (0)

constexpr int SHM_T = 16384;
struct AttDma { unsigned ko[2], vo[2]; };
__device__ __forceinline__ AttDma att_dma_init(int wave, int lane) {
    AttDma d;
#pragma unroll
    for (int i = 0; i < 2; ++i) { const int c = wave + 8 * i;
        { const int row = 4 * c + (lane >> 4), ch = (lane & 15) ^ (row & 7); d.ko[i] = (unsigned)(row * HW + ch * 8) * 2u; }
        { const int st = 2 * c + (lane >> 5), kk = (st >> 2) * 8 + ((lane & 31) >> 2), col = (st & 3) * 32 + 8 * (lane & 3);
          const int k = (kk & ~0xC) | ((kk & 4) << 1) | ((kk & 8) >> 1); d.vo[i] = (unsigned)(k * HW + col) * 2u; } }
    return d;
}
__device__ __forceinline__ void att_dma(const AttDma& d, const bf16* __restrict__ Kh, const bf16* __restrict__ Vh, int key0, LAS unsigned char* Kdst, LAS unsigned char* Vdst, int wave) {
    const __amdgpu_buffer_rsrc_t rk = __builtin_amdgcn_make_buffer_rsrc((void*)Kh, 0, 0x7fffffff, 0x00020000), rv = __builtin_amdgcn_make_buffer_rsrc((void*)Vh, 0, 0x7fffffff, 0x00020000);
    const int so = key0 * HW * 2;
#pragma unroll
    for (int i = 0; i < 2; ++i) { const int c = wave + 8 * i;
        __builtin_amdgcn_raw_ptr_buffer_load_lds(rk, (LAS void*)(Kdst + c * 1024), 16, (int)d.ko[i], so, 0, 0);
        __builtin_amdgcn_raw_ptr_buffer_load_lds(rv, (LAS void*)(Vdst + c * 1024), 16, (int)d.vo[i], so, 0, 0); }
}
__device__ __forceinline__ float half_sum32(float v) {
    v += __builtin_bit_cast(float, __builtin_amdgcn_update_dpp(0, __builtin_bit_cast(int, v), 0xB1, 0xf, 0xf, false));
    v += __builtin_bit_cast(float, __builtin_amdgcn_update_dpp(0, __builtin_bit_cast(int, v), 0x4E, 0xf, 0xf, false));
    v += __builtin_bit_cast(float, __builtin_amdgcn_update_dpp(0, __builtin_bit_cast(int, v), 0x141, 0xf, 0xf, false));
    v += __builtin_bit_cast(float, __builtin_amdgcn_update_dpp(0, __builtin_bit_cast(int, v), 0x140, 0xf, 0xf, false));
    return v + __shfl_xor(v, 16);
}
__device__ __forceinline__ void park2(LAS unsigned char* stg, int r, int hi, int r32, int d, float y0, float y1) {
    const unsigned w = cvt2bf(y0, y1); LAS unsigned char* rp = stg + crow(r, hi) * 256 + 2 * r32;
    *(LAS bf16*)(rp + 64 * (d ^ hi)) = (bf16)(w & 0xffffu); *(LAS bf16*)(rp + 64 * ((d + 1) ^ hi)) = (bf16)(w >> 16);
}
__device__ __forceinline__ void store_rows(const LAS unsigned char* stg, bf16* __restrict__ dst  , int lane) {
#pragma unroll
    for (int i = 0; i < 8; ++i) { const int row = (lane >> 4) + 4 * i, pc = lane & 15;
        const v4u w = *(const LAS v4u*)(stg + row * 256 + ((pc * 16) ^ ((i & 1) << 6)));
        *(v4u*)(dst + (size_t)row * DM + pc * 8) = w; }
}
__device__ __forceinline__ void da_unit(LAS unsigned char* lds, const bf16* __restrict__ Q, const bf16* __restrict__ Kp, const bf16* __restrict__ Vp, const float* __restrict__ gda, float lam,
                                        bf16* __restrict__ mixed, int b, int h, int qt, int tid, int wave, int lane) {
    constexpr float THR2 = 8.0f * 1.4426950408889634f;
    const int r32 = lane & 31, hi = lane >> 5, rg = wave & 3, comp = wave >> 2;
    LAS unsigned char* V_lds = lds; LAS unsigned char* K_lds = lds + 4 * SHM_T; LAS float* X = (LAS float*)lds;
    LAS float* wsf = (LAS float*)(lds + MISC_OFF + 2048) + wave * 64; LAS float* li_l = wsf; LAS float* al_l = wsf + 32;
    const int m0 = b * SEQ + 128 * qt;
    bf16x8 qr[4];
    { const bf16* Qw = Q + (size_t)(m0 + 32 * rg + r32) * HW + h * 128 + comp * 64 + hi * 8;
#pragma unroll
      for (int d0 = 0; d0 < 4; ++d0) qr[d0] = *(const bf16x8*)(Qw + d0 * 16); }
    const bf16* Kh = Kp + (size_t)(b * LPB) * HW + h * 128; const bf16* Vh = Vp + (size_t)(b * LPB) * HW + h * 128;
    const int vb0 = (int)(unsigned)(uintptr_t)V_lds + v_rd_base(lane);
    const int NT = 2 * qt + 3, NTw = 2 * qt + 2 + (rg >> 1);
    const AttDma dm = att_dma_init(wave, lane);
    att_dma(dm, Kh, Vh, 0, K_lds, V_lds, wave);
    att_dma(dm, Kh, Vh, 64, K_lds + SHM_T, V_lds + SHM_T, wave);
    int kbuf = 0;
    float m_reg = 0.f, l_reg = 0.f; f32x16 o[4];
    f32x16 mneg;
#pragma unroll
    for (int r = 0; r < 16; ++r) mneg[r] = 0.f;
#pragma unroll
    for (int d = 0; d < 4; ++d)
#pragma unroll
        for (int r = 0; r < 16; ++r) o[d][r] = 0.f;
    bf16x8 pa0, pa1, pa2, pa3; bool pend = false; int pbuf = 0, vbuf = 0;
#pragma unroll
    for (int q = 0; q < 8; ++q) { pa0[q] = 0; pa1[q] = 0; pa2[q] = 0; pa3[q] = 0; }
    for (int j = 0; j < NT; ++j) {
        const int buf = kbuf;
        if (j + 1 < NT) asm volatile("s_waitcnt vmcnt(4)" ::: "memory"); else asm volatile("s_waitcnt vmcnt(0)" ::: "memory");
        __syncthreads();
        if (j + 2 < NT) att_dma(dm, Kh, Vh, (j + 2) * 64, K_lds + (kbuf == 0 ? 2 : kbuf - 1) * SHM_T, V_lds + ((vbuf + 2) & 3) * SHM_T, wave);
        if (comp == 1 && pend) { pv_pipe(o, vb0 + pbuf * SHM_T, pa0, pa1, pa2, pa3); pend = false; }
        if (j < NTw) {
            f32x16 p0 = mneg, p1 = mneg;
            { const LAS unsigned char* Ks = K_lds + buf * SHM_T; bf16x8 kb0[4], kb1[4];
#pragma unroll
              for (int d0 = 0; d0 < 4; ++d0) { const int cb = (comp * 64 + d0 * 16 + hi * 8) * 2;
                  kb0[d0] = *(const LAS bf16x8*)(Ks + KSWZ(r32, cb)); kb1[d0] = *(const LAS bf16x8*)(Ks + KSWZ(32 + r32, cb)); }
              SBAR();
#pragma unroll
              for (int d0 = 0; d0 < 4; ++d0) { p0 = __builtin_amdgcn_mfma_f32_32x32x16_bf16(kb0[d0], qr[d0], p0, 0, 0, 0); p1 = __builtin_amdgcn_mfma_f32_32x32x16_bf16(kb1[d0], qr[d0], p1, 0, 0, 0); } }
            if (j == 0) {
#pragma unroll
                for (int r = 0; r < 16; ++r) p0[r] = -INFINITY;
#pragma unroll
                for (int r = 0; r < 8; ++r) p1[r] = -INFINITY;
            }
            float pmax = p0[0];
#pragma unroll
            for (int r = 1; r < 16; ++r) pmax = fmaxf(pmax, p0[r]);
#pragma unroll
            for (int r = 0; r < 16; ++r) pmax = fmaxf(pmax, p1[r]);
            { auto rr = __builtin_amdgcn_permlane32_swap(__builtin_bit_cast(unsigned, pmax), __builtin_bit_cast(unsigned, pmax), false, false);
              pmax = fmaxf(__builtin_bit_cast(float, rr[0]), __builtin_bit_cast(float, rr[1])); }
            float alpha = 1.f;
            if (j == 0 || !__all(pmax <= THR2)) {
                const float dl = j == 0 ? pmax : fmaxf(pmax, 0.f);
                alpha = j == 0 ? 1.f : __builtin_amdgcn_exp2f(-dl); m_reg += dl;
#pragma unroll
                for (int r = 0; r < 16; ++r) { p0[r] -= dl; p1[r] -= dl; mneg[r] = -m_reg; }
            }
#pragma unroll
            for (int r = 0; r < 16; ++r) { p0[r] = __builtin_amdgcn_exp2f(p0[r]); p1[r] = __builtin_amdgcn_exp2f(p1[r]); }
            if (__any(alpha < 1.f)) { if (hi == 0) al_l[r32] = alpha; asm volatile("s_waitcnt lgkmcnt(0)" ::: "memory");
#pragma unroll
                for (int r = 0; r < 16; ++r) { const float al = al_l[crow(r, hi)];
#pragma unroll
                    for (int d = 0; d < 4; ++d) o[d][r] *= al; } }
            float ps = 0.f;
#pragma unroll
            for (int r = 0; r < 16; ++r) ps += p0[r];
#pragma unroll
            for (int r = 0; r < 16; ++r) ps += p1[r];
            { auto rr = __builtin_amdgcn_permlane32_swap(__builtin_bit_cast(unsigned, ps), __builtin_bit_cast(unsigned, ps), false, false);
              ps = __builtin_bit_cast(float, rr[0]) + __builtin_bit_cast(float, rr[1]); }
            l_reg = l_reg * alpha + ps;
            ATT_PK4(p0, 0, pa0); ATT_PK4(p0, 8, pa1); ATT_PK4(p1, 0, pa2); ATT_PK4(p1, 8, pa3);
            if (comp == 0) pv_pipe(o, vb0 + vbuf * SHM_T, pa0, pa1, pa2, pa3); else { pend = true; pbuf = vbuf; }
        }
        vbuf = (vbuf + 1) & 3; kbuf = kbuf == 2 ? 0 : kbuf + 1;
    }
    if (pend) pv_pipe(o, vb0 + pbuf * SHM_T, pa0, pa1, pa2, pa3);
    if (hi == 0) li_l[r32] = l_reg;
    asm volatile("s_waitcnt lgkmcnt(0)" ::: "memory");
    float rli[16];
#pragma unroll
    for (int r = 0; r < 16; ++r) rli[r] = __builtin_amdgcn_rcpf(li_l[crow(r, hi)]);
    __syncthreads();
    if (comp == 1) {
#pragma unroll
        for (int r = 0; r < 16; ++r) { const float f = rli[r] * lam;
#pragma unroll
            for (int d = 0; d < 4; ++d) X[(rg * 32 + crow(r, hi)) * 128 + 32 * d + r32] = o[d][r] * f; }
    }
    __syncthreads();
    if (comp == 0) {
        float gg[4];
#pragma unroll
        for (int d = 0; d < 4; ++d) gg[d] = gda[h * 128 + 32 * d + r32] * (1.0f - LAM_INIT);
        LAS unsigned char* stg = lds + 4 * SHM_T + rg * 8192;
#pragma unroll
        for (int r = 0; r < 16; ++r) { float ss = 0.f; float v[4];
#pragma unroll
            for (int d = 0; d < 4; ++d) { v[d] = o[d][r] * rli[r] - X[(rg * 32 + crow(r, hi)) * 128 + 32 * d + r32]; ss += v[d] * v[d]; }
            ss = half_sum32(ss);
            const float rs = __builtin_amdgcn_rsqf(ss * (1.f / 128.f) + RMS_EPS);
            park2(stg, r, hi, r32, 0, v[0] * rs * gg[0], v[1] * rs * gg[1]); park2(stg, r, hi, r32, 2, v[2] * rs * gg[2], v[3] * rs * gg[3]); }
        store_rows(stg, mixed + (size_t)(m0 + 32 * rg) * DM + 1024 + h * 128, lane);
    }
    __syncthreads();
}

constexpr float SB_THR2 = -155.0f;
__device__ __forceinline__ void sb_block(f32x16& p, float& running, int kofs, int lo, int lim, bool need_mask, int hi) {
    constexpr float C1 = 0.08838834764831845f * 1.4426950408889634f;
    float L[16];
#pragma unroll
    for (int r = 0; r < 16; ++r) { const float z2 = p[r] * C1, t = __builtin_amdgcn_exp2f(-fabsf(z2)); const float sp = fmaxf(z2, 0.f) + __builtin_amdgcn_logf(1.0f + t);
        const int kk = kofs + crow(r, hi); const bool valid = !need_mask || (kk >= lo && kk < lim);
        L[r] = valid ? -sp : 0.f; p[r] = valid ? z2 : -1.0e30f; }
    float G[4], PG[4];
#pragma unroll
    for (int g = 0; g < 4; ++g) { G[g] = (L[4 * g] + L[4 * g + 1]) + (L[4 * g + 2] + L[4 * g + 3]); PG[g] = __shfl_xor(G[g], 32); }
#pragma unroll
    for (int g = 3; g >= 0; --g) { const float off = running + (hi == 0 ? PG[g] : 0.f);
        const float c3 = L[4 * g + 3] + off, c2 = L[4 * g + 2] + c3, c1 = L[4 * g + 1] + c2, c0 = L[4 * g] + c1;
        p[4 * g + 3] = __builtin_amdgcn_exp2f(p[4 * g + 3] + c3); p[4 * g + 2] = __builtin_amdgcn_exp2f(p[4 * g + 2] + c2);
        p[4 * g + 1] = __builtin_amdgcn_exp2f(p[4 * g + 1] + c1); p[4 * g] = __builtin_amdgcn_exp2f(p[4 * g] + c0);
        running += G[g] + PG[g]; }
}
__device__ __forceinline__ void sb_unit(LAS unsigned char* lds, const bf16* __restrict__ Q, const bf16* __restrict__ Kp, const bf16* __restrict__ Vp, const float* __restrict__ gsb,
                                        bf16* __restrict__ mixed, int b, int h, int qt, int tid, int wave, int lane) {
    const int r32 = lane & 31, hi = lane >> 5;
    LAS unsigned char* V_lds = lds; LAS unsigned char* K_lds = lds + 2 * SHM_T;
    LAS unsigned* fl = (LAS unsigned*)(lds + MISC_OFF + 4096);
    const int m0 = b * SEQ + 256 * qt;
    LAS unsigned char* Qs = lds + 4 * SHM_T + wave * 8192;
    { const bf16* Qw = Q + (size_t)(m0 + 32 * wave + r32) * HW + h * 128 + hi * 8;
#pragma unroll
      for (int d0 = 0; d0 < 8; ++d0) { const bf16x8 qv = *(const bf16x8*)(Qw + d0 * 16); *(LAS bf16x8*)(Qs + KSWZ(r32, (d0 * 16 + hi * 8) * 2)) = qv; } }
    const bf16* Kh = Kp + (size_t)(b * LPB) * HW + h * 128; const bf16* Vh = Vp + (size_t)(b * LPB) * HW + h * 128;
    const int vb0 = (int)(unsigned)(uintptr_t)V_lds + v_rd_base(lane);
    int kb[4];
#pragma unroll
    for (int bq = 0; bq < 4; ++bq) kb[bq] = r32 * 256 + ((bq * 32 + hi * 16) ^ ((r32 & 7) << 4));
    const int jtop = 4 * qt + 4, jw = 4 * qt + 1 + (wave >> 1);
    const int Prow = 64 + 256 * qt + 32 * wave + r32;
    if (lane == 0) { fl[wave] = 0u; fl[8 + wave] = 0u; }
    { const AttDma dm = att_dma_init(wave, lane); att_dma(dm, Kh, Vh, jtop * 64, K_lds, V_lds, wave); }
    float carry = 0.f; bool done = false; f32x16 o[4];
#pragma unroll
    for (int d = 0; d < 4; ++d)
#pragma unroll
        for (int r = 0; r < 16; ++r) o[d][r] = 0.f;
    for (int j = jtop, it = 0; j >= 0; --j, ++it) {
        const int buf = it & 1;
        asm volatile("s_waitcnt vmcnt(0)" ::: "memory");
        __syncthreads();
        if (it > 0) { const v4u f0 = *(const LAS v4u*)(fl + ((it - 1) & 1) * 8), f1 = *(const LAS v4u*)(fl + ((it - 1) & 1) * 8 + 4);
            if ((f0.x & f0.y & f0.z & f0.w & f1.x & f1.y & f1.z & f1.w) != 0u) break; }
        if (j > 0) { int z = 0; asm volatile("" : "+v"(z));
            const AttDma dm = att_dma_init(wave, lane + z); att_dma(dm, Kh, Vh, (j - 1) * 64, K_lds + (buf ^ 1) * SHM_T, V_lds + (buf ^ 1) * SHM_T, wave); }
        if (!done && j <= jw) {
            const bool need_mask = (j == jw) || (j == 0);
            const int lim = Prow - 64 * j, lo = (j == 0) ? KVPAD : 0;
            float running = carry;
            const LAS unsigned char* Ks = K_lds + buf * SHM_T;
            {   f32x16 p;
#pragma unroll
                for (int r = 0; r < 16; ++r) p[r] = 0.f;
#pragma unroll
                for (int d0 = 0; d0 < 8; ++d0) { const int ko = kb[d0 & 3] + (d0 >> 2) * 128;
                    const bf16x8 b1 = *(const LAS bf16x8*)(Ks + ko + 8192), qv = *(const LAS bf16x8*)(Qs + ko); p = __builtin_amdgcn_mfma_f32_32x32x16_bf16(b1, qv, p, 0, 0, 0); }
                sb_block(p, running, 32, lo, lim, need_mask, hi);
                bf16x8 paA, paB; ATT_PK4(p, 0, paA); ATT_PK4(p, 8, paB);
                pv_half<1>(o, vb0 + buf * SHM_T, paA, paB); }
            SBAR();
            {   f32x16 p;
#pragma unroll
                for (int r = 0; r < 16; ++r) p[r] = 0.f;
#pragma unroll
                for (int d0 = 0; d0 < 8; ++d0) { const int ko = kb[d0 & 3] + (d0 >> 2) * 128;
                    const bf16x8 b0 = *(const LAS bf16x8*)(Ks + ko), qv = *(const LAS bf16x8*)(Qs + ko); p = __builtin_amdgcn_mfma_f32_32x32x16_bf16(b0, qv, p, 0, 0, 0); }
                sb_block(p, running, 0, lo, lim, need_mask, hi);
                bf16x8 paA, paB; ATT_PK4(p, 0, paA); ATT_PK4(p, 8, paB);
                pv_half<0>(o, vb0 + buf * SHM_T, paA, paB); }
            carry = running;
            done = __all(carry < SB_THR2);
        }
        if (lane == 0) fl[(it & 1) * 8 + wave] = done ? 1u : 0u;
    }
    { float gg[4];
#pragma unroll
      for (int d = 0; d < 4; ++d) gg[d] = gsb[h * 128 + 32 * d + r32];
#pragma unroll
      for (int r = 0; r < 16; ++r) { float ss = 0.f;
#pragma unroll
          for (int d = 0; d < 4; ++d) ss += o[d][r] * o[d][r];
          ss = half_sum32(ss);
          const float rs = __builtin_amdgcn_rsqf(ss * (1.f / 128.f) + RMS_EPS);
          park2(Qs, r, hi, r32, 0, o[0][r] * rs * gg[0], o[1][r] * rs * gg[1]); park2(Qs, r, hi, r32, 2, o[2][r] * rs * gg[2], o[3][r] * rs * gg[3]); }
      store_rows(Qs, mixed + (size_t)(m0 + 32 * wave) * DM + h * 128, lane); }
    __syncthreads();
}
}

__device__ __forceinline__ void phase_attn(const Args& a, LAS unsigned char* lds, int vcu, int G, int tid, int lane, int wave) {
    unsigned char* ws = a.ws;
    const float lam = ((const float*)(ws + WS_CTL))[CW_LAM];
    for (int idx = vcu; idx < 256; idx += G) {
        const int s16 = idx & 15;
        for (int k = 0; k < 4; ++k) { const int bh = ((idx >> 5) << 2) + 2 * (k >> 1) + ((idx >> 4) & 1), b = bh >> 3, h = bh & 7, qt = (k & 1) ? 31 - s16 : s16;
            att::da_unit(lds, (const bf16*)(ws + WS_DAQ), (const bf16*)(ws + WS_DAK), (const bf16*)(ws + WS_DAV), a.in[I_GDA], lam, (bf16*)(ws + WS_MIX), b, h, qt, tid, wave, lane); }
    }
    for (int idx = vcu; idx < 256; idx += G) {
        const int bh = idx >> 3, s = idx & 7, b = bh >> 3, h = bh & 7;
        for (int k = 0; k < 2; ++k)
            att::sb_unit(lds, (const bf16*)(ws + WS_SBQ), (const bf16*)(ws + WS_SBK), (const bf16*)(ws + WS_SBV), a.in[I_GSB], (bf16*)(ws + WS_MIX), b, h, 2 * s + k, tid, wave, lane);
    }
}

enum { PH_PRO = 0, PH_INPROJ, PH_ATTN, PH_OUTPROJ, PH_ROUTE, PH_GATEUP, PH_DOWN, PH_FINAL, PH_N };
__global__ void __launch_bounds__(NWAVES * 64, 2) fwd(Args args) {
    extern __shared__ __attribute__((aligned(16))) unsigned char lds_raw[];
    LAS unsigned char* lds = (LAS unsigned char*)lds_raw;
    const int tid = threadIdx.x, lane = tid & 63, wave = __builtin_amdgcn_readfirstlane(tid >> 6);
    const int G = gridDim.x; const int bx = blockIdx.x; const int vcu = (G % 8 == 0) ? (bx % 8) * (G / 8) + bx / 8 : bx;
    unsigned char* ws = args.ws;
    unsigned* ctl = (unsigned*)(ws + WS_CTL);
    volatile LAS unsigned* MISC = (volatile LAS unsigned*)(lds + MISC_OFF);
    if (tid < 64) MISC[tid] = 0u;
    __syncthreads();
    XcdBarrier bar; bar.bar = ctl + CW_BAR; bar.x = 0; bar.st = MISC + 8;
    const int lo = args.ph_lo, hi = args.ph_hi;
    if (hi - lo > 1) bar = xcd_barrier_post(ctl + CW_BAR, MISC + 8);
#define IN(k) (lo <= (k) && (k) < hi)
#define SEAM(k) do { if (IN(k) && IN((k) + 1)) xcd_barrier(bar); } while (0)

    if (IN(PH_PRO)) { for (int rep = 0; rep < REP_PRO; ++rep) phase0(args, lds, vcu, G, tid, lane, wave); SEAM(PH_PRO); }
    if (IN(PH_INPROJ)) {
        pg8::DenseOrder S; S.init((const bf16*)(ws + WS_U), (const bf16*)(ws + WS_WIN), NTOK, INCOLS, G, bx);
        pg8::EpiProj E{(bf16*)(ws + WS_SBQ), (bf16*)(ws + WS_SBK), (bf16*)(ws + WS_SBV), (bf16*)(ws + WS_DAQ), (bf16*)(ws + WS_DAK), (bf16*)(ws + WS_DAV), (const float*)(ws + WS_ROPE)};
        if ((vcu & 1) == 0) conv_slice(args, lds, 0, vcu, G, lane, wave);
        for (int rep = 0; rep < REP_INPROJ; ++rep) pg8::gemm_phase<pg8::EpiProj, pg8::DenseOrder>(lds, S, E);
        if ((vcu & 1) != 0) conv_slice(args, lds, 0, vcu, G, lane, wave);
        SEAM(PH_INPROJ);
    }
    if (IN(PH_ATTN)) { if ((vcu & 1) == 0) conv_slice(args, lds, 1, vcu, G, lane, wave);
        for (int rep = 0; rep < REP_ATTN; ++rep) phase_attn(args, lds, vcu, G, tid, lane, wave);
        __syncthreads(); if ((vcu & 1) != 0) conv_slice(args, lds, 1, vcu, G, lane, wave); SEAM(PH_ATTN); }
    if (IN(PH_OUTPROJ)) {
        pg8::DenseOrder S; S.init((const bf16*)(ws + WS_MIX), (const bf16*)(ws + WS_WOUT), NTOK, DM, G, bx);
        pg8::EpiRes E{args.in[I_X], (bf16*)(ws + WS_U)};
        if ((vcu & 1) == 0) conv_slice(args, lds, 2, vcu, G, lane, wave);
        pg8::gemm_phase<pg8::EpiRes, pg8::DenseOrder>(lds, S, E);
        if ((vcu & 1) != 0) conv_slice(args, lds, 2, vcu, G, lane, wave);
        SEAM(PH_OUTPROJ);
    }
    if (IN(PH_ROUTE)) { phase4(args, lds, vcu, G, tid, lane, wave); SEAM(PH_ROUTE); }
    if (IN(PH_GATEUP)) {
        const int ntiles = __builtin_amdgcn_readfirstlane(moe_build_tiles(args, lds, tid));
        pg8::MoeOrder<true> S; S.init((const bf16*)(ws + WS_U2), (const bf16*)(ws + WS_WGU), ntiles, 4096, lds, ctl + CW_QUEUE + 64 * (bx & 7), bx & 7);
        {
            const LAS int* tp = (const LAS int*)(lds + MISC_OFF + 1024); const LAS unsigned* cn = (const LAS unsigned*)(lds + CNT_OFF); const LAS int* te = (const LAS int*)(lds + TE_OFF);
            LAS unsigned short* gidx = (LAS unsigned short*)(lds + IDX_OFF); const int* elist = (const int*)(ws + WS_ELIST);
            const int total = (ntiles - S.mlo < IDX_TILES ? ntiles - S.mlo : IDX_TILES) * 256;
            int vals[IDX_TILES / 2];
#pragma unroll
            for (int k = 0; k < IDX_TILES / 2; ++k) { int q = tid + 512 * k; q = q < total ? q : total - 1;
                const int T = S.mlo + (q >> 8), e = te[T], rank = (T - tp[e]) * 256 + (q & 255); vals[k] = elist[(size_t)e * NTOK + (rank < (int)cn[e] ? rank : 0)]; }
#pragma unroll
            for (int k = 0; k < IDX_TILES / 2; ++k) { const int q = tid + 512 * k; if (q < total) gidx[q] = (unsigned short)vals[k]; }
        }
        S.prefetch(0); S.prefetch(1); __syncthreads();
        pg8::EpiSwiglu E{(bf16*)(ws + WS_ACT), args.in[I_BGU]};
        {
            const int cut = 2 * (vcu & 7);
#pragma unroll 1
            for (int part = 0; part < 2; ++part) {
                if (part == 1) { int z = 0; asm volatile("" : "+s"(z));
                    conv_slice(args, lds, 3, vcu + z, G, lane + z, wave + z); }
                S.base = part ? (S.ndone < cut ? S.ndone : cut) : 0; S.cap = part ? (1 << 30) : cut;
                S.ndone = 0;
                if (S.cap > 0) pg8::gemm_phase<pg8::EpiSwiglu, pg8::MoeOrder<true>>(lds, S, E);
            }
        }
        SEAM(PH_GATEUP);
    }
    if (IN(PH_DOWN)) {
        const int ntiles = __builtin_amdgcn_readfirstlane(moe_build_tiles(args, lds, tid));
        pg8::MoeOrder<false> S; S.init((const bf16*)(ws + WS_ACT), (const bf16*)(ws + WS_WDN), ntiles, DM, lds, ctl + CW_QUEUE + 64 * (8 + (bx & 7)), bx & 7);
        S.prefetch(0); S.prefetch(1); __syncthreads();
        pg8::EpiDown E{(bf16*)(ws + WS_YS), args.in[I_BDN]};
        for (int rep = 0; rep < REP_DOWN; ++rep) pg8::gemm_phase<pg8::EpiDown, pg8::MoeOrder<false>>(lds, S, E);
        SEAM(PH_DOWN);
    }
    if (IN(PH_FINAL)) { phase7(args, lds, vcu, G, tid, lane, wave); }
#undef IN
#undef SEAM
}

extern "C" void kernel_launch(void* const* d_in, const int* in_sizes, int n_in, void* d_out, int out_size, void* d_ws, size_t ws_size, hipStream_t stream) {
    static int grid = 0;
    if (grid == 0) {
        if (n_in != 19 || out_size != NTOK * DM || ws_size < WS_END) { fprintf(stderr, "kernel_launch: unexpected shapes (n_in %d out %d ws %zu)\n", n_in, out_size, ws_size); grid = -1; return; }
        int dev = 0, cus = 0, per_cu = 0;
        if (hipGetDevice(&dev) != hipSuccess || hipDeviceGetAttribute(&cus, hipDeviceAttributeMultiprocessorCount, dev) != hipSuccess) { grid = -1; return; }
        if (hipFuncSetAttribute((const void*)fwd, hipFuncAttributeMaxDynamicSharedMemorySize, LDS_BYTES) != hipSuccess) { fprintf(stderr, "kernel_launch: hipFuncSetAttribute failed\n"); grid = -1; return; }
        if (hipOccupancyMaxActiveBlocksPerMultiprocessor(&per_cu, (const void*)fwd, NWAVES * 64, LDS_BYTES) != hipSuccess || per_cu < 1) { fprintf(stderr, "kernel_launch: occupancy query says %d\n", per_cu); }
        (void)hipGetLastError();
        grid = cus;
    }
    if (grid < 0) return;
    (void)in_sizes;
    (void)hipMemsetAsync((char*)d_ws + WS_CTL, 0, CTL_ZERO_BYTES, stream);
    Args a{};
    for (int i = 0; i < 19; ++i) a.in[i] = (const float*)d_in[i];
    a.out = (float*)d_out; a.ws = (unsigned char*)d_ws;
#if N_LAUNCH_MODE == 1
    a.ph_lo = 0; a.ph_hi = PH_N;
    hipLaunchKernelGGL(fwd, dim3(grid), dim3(NWAVES * 64), LDS_BYTES, stream, a);
#else
    for (int ph = 0; ph < PH_N; ++ph) {
        a.ph_lo = ph; a.ph_hi = ph + 1;
        hipLaunchKernelGGL(fwd, dim3(grid), dim3(NWAVES * 64), LDS_BYTES, stream, a);
    }
#endif
    const hipError_t le = hipPeekAtLastError();
    if (le != hipSuccess) fprintf(stderr, "kernel_launch: launch failed: %s\n", hipGetErrorName(le));
}
```

```cpp
#include <hip/hip_runtime.h>
#include <cstdio>
#include <cstdint>

#ifndef REP_PRO
#define REP_PRO 1
#endif
#ifndef REP_INPROJ
#define REP_INPROJ 1
#endif
#ifndef REP_ATTN
#define REP_ATTN 1
#endif
#ifndef REP_GU
#define REP_GU 1
#endif
#ifndef REP_DOWN
#define REP_DOWN 1
#endif
#ifndef N_LAUNCH_MODE
#define N_LAUNCH_MODE 1
#endif

constexpr int BATCH = 4, SEQ = 4096, DM = 2048, NTOK = BATCH * SEQ;
constexpr int NMETA = 16, KVPAD = 48, LPB = 4160;
constexpr int HW = 1024;
constexpr int INCOLS = 6144;
constexpr int NEXP = 32, TOPK = 4;
constexpr int MAXTILES = 288, NPADROWS = MAXTILES * 256;
constexpr float RMS_EPS = 1e-5f;
constexpr float LAM_INIT = 0.2f;

constexpr size_t MiB = 1u << 20;
constexpr size_t WS_CTL = 0, CTL_ZERO_BYTES = 1 * MiB;
constexpr size_t WS_ROPE = 1 * MiB;
constexpr size_t WS_WIN = 2 * MiB;
constexpr size_t WS_WOUT = 26 * MiB;
constexpr size_t WS_U = 34 * MiB;
constexpr size_t WS_SBQ = 98 * MiB, WS_DAQ = 130 * MiB;
constexpr size_t WS_SBK = 162 * MiB, WS_SBV = 195 * MiB, WS_DAK = 228 * MiB, WS_DAV = 261 * MiB;
constexpr size_t WS_MIX = 294 * MiB;
constexpr size_t WS_U2 = 358 * MiB;
constexpr size_t WS_ROUTE = 422 * MiB;
constexpr size_t WS_ELIST = 424 * MiB;
constexpr size_t WS_WG = 1 * MiB + 512 * 1024;
constexpr size_t WS_ACT = 712 * MiB;
constexpr size_t WS_YS = 1000 * MiB;
constexpr size_t WS_WGU = 1288 * MiB;
constexpr size_t WS_WDN = 1800 * MiB;
constexpr size_t WS_END = 2056 * MiB;
constexpr int CW_TMO = 0, CW_LAM = 16, CW_NTILES = 32, CW_BAR = 4096, CW_CNT = 8192  , CW_TILE_E = 12288  , CW_QUEUE = 16384  ;

constexpr int LDS_BYTES = 163840;
constexpr int MISC_OFF = 131072;
constexpr int TE_OFF = MISC_OFF + 4608;
constexpr int CNT_OFF = MISC_OFF + 1280;
constexpr int IDX_OFF = MISC_OFF + 8192;
constexpr int IDX_TILES = 48;
constexpr int TICK_OFF = MISC_OFF + 7168;

#define GAS __attribute__((address_space(1)))
#define LAS __attribute__((address_space(3)))
typedef unsigned short bf16;
typedef unsigned v4u __attribute__((ext_vector_type(4)));
typedef unsigned v2u __attribute__((ext_vector_type(2)));
typedef float f32x4 __attribute__((ext_vector_type(4)));
typedef float f32x16 __attribute__((ext_vector_type(16)));
typedef short bf16x8 __attribute__((ext_vector_type(8)));
#define LDS_WAIT() asm volatile("s_waitcnt lgkmcnt(0)" ::: "memory")
#define VM_WAIT() asm volatile("s_waitcnt vmcnt(0)" ::: "memory")

__device__ __forceinline__ unsigned f2bf(float f) { unsigned u = __builtin_bit_cast(unsigned, f); return (u + 0x7fffu + ((u >> 16) & 1u)) >> 16; }
__device__ __forceinline__ unsigned pk2(float lo, float hi) { return f2bf(lo) | (f2bf(hi) << 16); }
__device__ __forceinline__ float bf2f(unsigned short b) { return __builtin_bit_cast(float, (unsigned)b << 16); }
__device__ __forceinline__ float bflo(unsigned w) { return __builtin_bit_cast(float, w << 16); }
__device__ __forceinline__ float bfhi(unsigned w) { return __builtin_bit_cast(float, w & 0xffff0000u); }
typedef __bf16 bf16x2_t __attribute__((ext_vector_type(2)));
typedef float f32x2_t __attribute__((ext_vector_type(2)));
__device__ __forceinline__ unsigned cvt2bf(float lo, float hi) { const f32x2_t v = {lo, hi}; const bf16x2_t r = __builtin_convertvector(v, bf16x2_t); return __builtin_bit_cast(unsigned, r); }
__device__ __forceinline__ float wave_sum(float v) {
#pragma unroll
    for (int o = 1; o < 64; o <<= 1) v += __shfl_xor(v, o);
    return v;
}

#define XB_TMO      128
#define XB_XCNT(j)  (256  + 64 * (j))
#define XB_XSUB(j)  (1280 + 64 * (j))
#define XB_XGEN(j)  (2304 + 64 * (j))
#define XB_TOP      3328
#define XB_TOPGEN   3392
#define XCD_BAR_WORDS 3456
#define XB_SPIN_CAP (1u << 22)
__device__ __forceinline__ unsigned xb_ld(unsigned* p)              { return __hip_atomic_load(p, __ATOMIC_RELAXED, __HIP_MEMORY_SCOPE_AGENT); }
__device__ __forceinline__ unsigned xb_add(unsigned* p, unsigned v) { return __hip_atomic_fetch_add(p, v, __ATOMIC_RELAXED, __HIP_MEMORY_SCOPE_AGENT); }
__device__ __forceinline__ unsigned xb_xcc_id() { return (unsigned)__builtin_amdgcn_s_getreg((3 << 11) | 20) & 0xFu; }
#define XB_SPIN(cond, bar) do { unsigned _sp = 0; while (cond) { __builtin_amdgcn_s_sleep(1); \
    if ((++_sp & 255u) == 0u) { if (xb_ld(&(bar)[XB_TMO])) break; if (_sp > XB_SPIN_CAP) { atomicAdd(&(bar)[XB_TMO], 1u); break; } } } } while (0)
struct XcdBarrier { unsigned* bar; unsigned x; volatile LAS unsigned* st; };
__device__ __forceinline__ XcdBarrier xcd_barrier_post(unsigned* bar, volatile LAS unsigned* st) {
    XcdBarrier b; b.bar = bar; b.x = xb_xcc_id(); b.st = st;
    if (threadIdx.x == 0) (void)xb_add(&bar[XB_XCNT(b.x)], 1u);
    return b;
}
__device__ __forceinline__ void xcd_barrier_complete(unsigned* bar, unsigned x, unsigned& nloc, unsigned& nx) {
    const unsigned G = gridDim.x * gridDim.y * gridDim.z;
    unsigned sum, cnt, mine, sp = 0u;
    for (;;) {
        sum = 0u; cnt = 0u; mine = 0u;
#pragma unroll
        for (unsigned j = 0; j < 16; ++j) { const unsigned c = xb_ld(&bar[XB_XCNT(j)]); sum += c; cnt += (c > 0u) ? 1u : 0u; mine = (j == x) ? c : mine; }
        if (sum == G) break;
        __builtin_amdgcn_s_sleep(1);
        if ((++sp & 255u) == 0u) { if (xb_ld(&bar[XB_TMO])) break; if (sp > XB_SPIN_CAP) { atomicAdd(&bar[XB_TMO], 1u); break; } }
    }
    nloc = mine > 0u ? mine : 1u; nx = cnt > 0u ? cnt : 1u;
}
__device__ __forceinline__ void xcd_barrier(const XcdBarrier& b) {
    asm volatile("s_waitcnt vmcnt(0)" ::: "memory");
    __syncthreads();
    if (threadIdx.x == 0) {
        unsigned* bar = b.bar;
        __builtin_amdgcn_s_waitcnt(0);
        unsigned nloc = b.st[0], nx = b.st[1];
        if (nloc == 0u) { xcd_barrier_complete(bar, b.x, nloc, nx); b.st[0] = nloc; b.st[1] = nx; }
        const unsigned old = xb_add(&bar[XB_XSUB(b.x)], 1u);
        const unsigned gen = old / nloc;
        if (old + 1u == (gen + 1u) * nloc) {
            __builtin_amdgcn_fence(__ATOMIC_RELEASE, "agent");
            asm volatile("s_waitcnt vmcnt(0)" ::: "memory");
            const unsigned og = xb_add(&bar[XB_TOP], 1u);
            const unsigned tg = og / nx;
            if (og + 1u == (tg + 1u) * nx) xb_add(&bar[XB_TOPGEN], 1u);
            else XB_SPIN(xb_ld(&bar[XB_TOPGEN]) == tg, bar);
            __builtin_amdgcn_fence(__ATOMIC_ACQUIRE, "agent");
            xb_add(&bar[XB_XGEN(b.x)], 1u);
            asm volatile("s_waitcnt vmcnt(0)" ::: "memory");
        } else {
            XB_SPIN(xb_ld(&bar[XB_XGEN(b.x)]) == gen, bar);
            __builtin_amdgcn_fence(__ATOMIC_ACQUIRE, "agent");
            asm volatile("s_waitcnt vmcnt(0)" ::: "memory");
        }
    }
    __syncthreads();
}

namespace pg8 {
constexpr int BM = 256, BK = 64, HALF = 128, HTB = HALF * BK * 2, STAGE_BYTES = 8 * HTB, NXCD = 8, WGM = 8;
constexpr int KDIM = 2048;
__host__ __device__ __forceinline__ int lds_byte(int r, int c) { const int st = (r >> 4) * 2 + (c >> 5), rr = r & 15, cc = c & 31, ob = rr * 64 + cc * 2; return st * 1024 + (ob ^ (((ob >> 9) & 1) << 5)); }
__host__ __device__ __forceinline__ void stage_rc(int b, int& R, int& C) { const int st = b / 1024, sb = b % 1024, swz = sb ^ (((sb >> 9) & 1) << 5); R = (st >> 1) * 16 + swz / 64; C = (st & 1) * 32 + (swz % 64) / 2; }
__host__ __device__ __forceinline__ int perm32(int rho) { const int n = rho >> 4, i = rho & 15; return 8 * (i >> 2) + 4 * n + (i & 3); }

struct Unit { int pm, pn, e, vr; const char* a; const char* b; };

struct DenseOrder {
    static constexpr bool GATHER = false;
    int nM, nN, nwg, G, c, first = 0, count = 1 << 30; const char* A; const char* Bt;
    __device__ __forceinline__ void prefetch(int) const {}
    __device__ void init(const bf16* A_, const bf16* Bt_, int M, int N, int G_, int c_) { nM = M / BM; nN = N / BM; nwg = nM * nN; G = G_; c = c_; A = (const char*)A_; Bt = (const char*)Bt_; }
    __device__ __forceinline__ bool next(int i, Unit& u) const {
        if (i >= count) return false; i += first;
        const long L = (long)i * G + c; if (L >= nwg) return false;
        int wgid = (int)L; { const int q = nwg / NXCD, r = nwg % NXCD, xcd = wgid % NXCD, off = wgid / NXCD; wgid = (xcd < r ? xcd * (q + 1) : r * (q + 1) + (xcd - r) * q) + off; }
        const int nig = WGM * nN, gid = wgid / nig, fm = gid * WGM, gsz = (nM - fm) < WGM ? (nM - fm) : WGM;
        u.pm = fm + ((wgid % nig) % gsz); u.pn = (wgid % nig) / gsz; u.e = 0; u.vr = BM;
        u.a = A + (size_t)u.pm * (size_t)(BM * KDIM * 2); u.b = Bt + (size_t)u.pn * (size_t)(BM * KDIM * 2); return true;
    }
};
template <bool GATH> struct MoeOrder {
    static constexpr bool GATHER = GATH;
    int nM, nN, nwg, lo, sz, mlo, base = 0, cap = 1 << 30;
    mutable int ndone = 0;
    const char* A; const char* Bt; const LAS int* te; const LAS int* tpx; const LAS unsigned* cnx; LAS int* tick; unsigned* qctr; size_t estride;
    __device__ void init(const bf16* A_, const bf16* Bt_, int ntiles, int NE, LAS unsigned char* lds, unsigned* qctr_, int q8) {
        nM = ntiles; nN = NE / BM; nwg = nM * nN; A = (const char*)A_; Bt = (const char*)Bt_; estride = (size_t)NE * KDIM * 2;
        te = (const LAS int*)(lds + TE_OFF); tpx = (const LAS int*)(lds + MISC_OFF + 1024); cnx = (const LAS unsigned*)(lds + CNT_OFF); tick = (LAS int*)(lds + TICK_OFF); qctr = qctr_;
        const int q = nwg / NXCD, r = nwg % NXCD; lo = q8 < r ? q8 * (q + 1) : r * (q + 1) + (q8 - r) * q; sz = q8 < r ? q + 1 : q;
        mlo = WGM * (lo / (WGM * nN)); }
    __device__ __forceinline__ void decode(int wgid, Unit& u) const {
        const int nig = WGM * nN, gid = wgid / nig, fm = gid * WGM, gsz = (nM - fm) < WGM ? (nM - fm) : WGM;
        u.pm = fm + ((wgid % nig) % gsz); u.pn = (wgid % nig) / gsz;
        u.e = __builtin_amdgcn_readfirstlane(te[u.pm]);
        { const int left = (int)cnx[u.e] - (u.pm - tpx[u.e]) * BM; u.vr = __builtin_amdgcn_readfirstlane(left < BM ? left : BM); }
        u.a = A + (size_t)u.pm * (size_t)(BM * KDIM * 2); u.b = Bt + (size_t)u.e * estride + (size_t)u.pn * (size_t)(BM * KDIM * 2); }
    __device__ __forceinline__ void prefetch(int i) const { if (threadIdx.x == 0) tick[(base + i) & 3] = (int)__hip_atomic_fetch_add(qctr, 1u, __ATOMIC_RELAXED, __HIP_MEMORY_SCOPE_AGENT); }
    __device__ __forceinline__ bool next(int i, Unit& u) const {
        if (i >= cap) return false;
        const int t = __builtin_amdgcn_readfirstlane(tick[(base + i) & 3]); if (t >= sz) return false;
        ndone = i + 1 > ndone ? i + 1 : ndone;
        decode(lo + t, u); return true; }
};

__device__ __forceinline__ unsigned cvt_pk_bf16(float lo, float hi) { return cvt2bf(lo, hi); }

template <class Epi, class Sched>
__device__ __forceinline__ void gemm_phase(LAS unsigned char* lds, const Sched& S, const Epi& E) {
    const int tid = threadIdx.x, wid = __builtin_amdgcn_readfirstlane(tid >> 6), lane = tid & 63, wr = wid >> 2, wc = wid & 3, fr = lane & 15, fq = lane >> 4;
    constexpr int K = KDIM, nt = K / BK;
    unsigned voffA[2], voffB[2];
#pragma unroll
    for (int i = 0; i < 2; ++i) { int R, C; stage_rc(tid * 16 + i * 8192, R, C); const int Rb = Epi::PERM ? ((R & ~31) + perm32(R & 31)) : R;
        voffA[i] = (unsigned)(R * K + C) * 2u; voffB[i] = (unsigned)(Rb * K + C) * 2u; }
    const size_t kstep = (size_t)(BK * 2);
    const size_t hstep = (size_t)HALF * K * 2;
    const unsigned ldsw = (unsigned)wid * 1024u;
    const int aoff = lds_byte(wr * 64 + fr, fq * 8), boff = lds_byte(wc * 32 + fr, fq * 8);
    unsigned vg[2][2] = {{0u, 0u}, {0u, 0u}}, nvg[2][2] = {{0u, 0u}, {0u, 0u}};
    const LAS unsigned short* gidx = (const LAS unsigned short*)(lds + IDX_OFF);
#define PG8_GIDX(dst, u_) do { int mt_ = 0; if constexpr (Sched::GATHER) mt_ = (u_).pm - S.mlo; mt_ = mt_ < 0 ? 0 : (mt_ < IDX_TILES ? mt_ : IDX_TILES - 1); \
    _Pragma("unroll") for (int _i = 0; _i < 2; ++_i) { int R_, C_; stage_rc(tid * 16 + _i * 8192, R_, C_); _Pragma("unroll") for (int _h = 0; _h < 2; ++_h) \
        dst[_h][_i] = (unsigned)gidx[mt_ * 256 + _h * HALF + R_] * (unsigned)(K * 2) + (unsigned)C_ * 2u; } } while (0)
#define PG8_SA(b, h) (((b) * 2 + (h)) * HTB)
#define PG8_SB(b, h) ((4 + (b) * 2 + (h)) * HTB)
#define PG8_STAGE_R(bufoff, gbase, voff, RS, BASE) do { const int so_ = (int)(unsigned)((const char*)(gbase) - (BASE)); _Pragma("unroll") for (int _i = 0; _i < 2; ++_i) \
        __builtin_amdgcn_raw_ptr_buffer_load_lds(RS, (LAS void*)(lds + (bufoff) + ldsw + _i * 8192), 16, (int)(voff)[_i], so_, 0, 0); } while (0)
#define PG8_STAGE(bufoff, gbase, voff) PG8_STAGE_R(bufoff, gbase, voff, rsB, S.Bt)
#define PG8_STAGE_A(bufoff, kofs, h, nx) do { if constexpr (Sched::GATHER) { const int so_ = (int)(unsigned)(kofs); \
        _Pragma("unroll") for (int _i = 0; _i < 2; ++_i) { const unsigned vo_ = (nx) ? nvg[h][_i] : vg[h][_i]; \
            __builtin_amdgcn_raw_ptr_buffer_load_lds(rsA, (LAS void*)(lds + (bufoff) + ldsw + _i * 8192), 16, (int)vo_, so_, 0, 0); } } \
    else { PG8_STAGE_R(bufoff, ((nx) ? nA : cA) + (size_t)(kofs) + (size_t)(h) * hstep, voffA, rsA, S.A); } } while (0)
#define PG8_LDA(dst, b, h) do { _Pragma("unroll") for (int m = 0; m < 4; ++m) _Pragma("unroll") for (int k = 0; k < 2; ++k) dst[m][k] = *(const LAS bf16x8*)(lds + PG8_SA(b, h) + aoff + m * 2048 + k * 1024); } while (0)
#define PG8_LDB(dst, b, h) do { _Pragma("unroll") for (int n = 0; n < 2; ++n) _Pragma("unroll") for (int k = 0; k < 2; ++k) dst[n][k] = *(const LAS bf16x8*)(lds + PG8_SB(b, h) + boff + n * 2048 + k * 1024); } while (0)
#define PG8_MMA1(ai, bj, At, Bt) do { _Pragma("unroll") for (int m = 0; m < 4; ++m) _Pragma("unroll") for (int n = 0; n < 2; ++n) _Pragma("unroll") for (int k = 0; k < 2; ++k) \
        acc[ai][bj][m][n] = __builtin_amdgcn_mfma_f32_16x16x32_bf16(Bt[n][k], At[m][k], acc[ai][bj][m][n], 0, 0, 0); } while (0)
#define PG8_MMA2(ai, At) do { __builtin_amdgcn_s_setprio(1); PG8_MMA1(ai, 0, At, B0); PG8_MMA1(ai, 1, At, B1); __builtin_amdgcn_s_setprio(0); } while (0)
#define PG8_WAIT_V(n) asm volatile("s_waitcnt vmcnt(" #n ")" ::: "memory")
#define PG8_WAIT_L(n) asm volatile("s_waitcnt lgkmcnt(" #n ")" ::: "memory")
#define PG8_BAR __builtin_amdgcn_s_barrier()
#define PG8_SCHED __builtin_amdgcn_sched_barrier(0)
    Unit cur, nxt; int ui = 0;
    if (!S.next(0, cur)) return;
    LAS float* bxw = (LAS float*)(lds + MISC_OFF + 2048) + wid * 64;
    float b1 = E.pre(cur, wc, lane);
    const __amdgpu_buffer_rsrc_t rsA = __builtin_amdgcn_make_buffer_rsrc((void*)S.A, 0, 0x7fffffff, 0x00020000), rsB = __builtin_amdgcn_make_buffer_rsrc((void*)S.Bt, 0, 0x7fffffff, 0x00020000);
    f32x4 acc[2][2][4][2];
#pragma unroll
    for (int a = 0; a < 2; ++a)
#pragma unroll
        for (int b = 0; b < 2; ++b)
#pragma unroll
            for (int m = 0; m < 4; ++m)
#pragma unroll
                for (int n = 0; n < 2; ++n) acc[a][b][m][n] = (f32x4){0.f, 0.f, 0.f, 0.f};
    bf16x8 At[4][2], B0[2][2], B1[2][2];
    const char* cA = cur.a; const char* cB = cur.b;
    const char* nA = cA;
    if constexpr (Sched::GATHER) { PG8_GIDX(vg, cur); }
    PG8_STAGE(PG8_SB(0, 0), cB, voffB); PG8_STAGE(PG8_SB(0, 1), cB + hstep, voffB); PG8_STAGE_A(PG8_SA(0, 0), 0, 0, false); PG8_STAGE_A(PG8_SA(0, 1), 0, 1, false);
    if (wr == 1) PG8_BAR;
    PG8_WAIT_V(2); PG8_BAR;
    PG8_STAGE(PG8_SB(1, 0), cB + kstep, voffB); PG8_STAGE_A(PG8_SA(1, 0), kstep, 0, false); PG8_STAGE(PG8_SB(1, 1), cB + hstep + kstep, voffB);
    PG8_WAIT_V(6); PG8_BAR;
    for (;;) {
        const bool has_next = S.next(ui + 1, nxt);
        S.prefetch(ui + 2);
        nA = has_next ? nxt.a : cA; const char* nB = has_next ? nxt.b : cB;
#define PG8_KLOOP(LIVE1) do { \
        for (int t = 0; t < nt; t += 2) { \
            const bool last = (t == nt - 2); \
            if constexpr (Sched::GATHER) { if (last) { if (has_next) { PG8_GIDX(nvg, nxt); } else { PG8_GIDX(nvg, cur); } } } \
            const size_t k1 = (size_t)(t + 1) * kstep, k2 = last ? (size_t)0 : (size_t)(t + 2) * kstep, k3 = k2 + kstep; \
            const char* b2 = last ? nB : cB + (size_t)(t + 2) * kstep; const char* b3 = b2 + kstep; \
            PG8_LDB(B0, 0, 0); PG8_LDB(B1, 0, 1); PG8_SCHED; PG8_LDA(At, 0, 0); PG8_STAGE_A(PG8_SA(1, 1), k1, 1, false); \
            PG8_WAIT_V(8); PG8_WAIT_L(0); PG8_BAR; PG8_MMA2(0, At); PG8_BAR; PG8_SCHED; \
            if (LIVE1) { PG8_LDA(At, 0, 1); } PG8_STAGE(PG8_SB(0, 0), b2, voffB); PG8_STAGE(PG8_SB(0, 1), b2 + hstep, voffB); PG8_STAGE_A(PG8_SA(0, 0), k2, 0, last); \
            PG8_WAIT_V(8); PG8_WAIT_L(0); PG8_BAR; if (LIVE1) { PG8_MMA2(1, At); } PG8_BAR; PG8_SCHED; \
            PG8_LDB(B0, 1, 0); PG8_LDB(B1, 1, 1); PG8_SCHED; PG8_LDA(At, 1, 0); PG8_STAGE_A(PG8_SA(0, 1), k2, 1, last); \
            PG8_WAIT_V(8); PG8_WAIT_L(0); PG8_BAR; PG8_MMA2(0, At); PG8_BAR; PG8_SCHED; \
            if (LIVE1) { PG8_LDA(At, 1, 1); } PG8_STAGE(PG8_SB(1, 0), b3, voffB); PG8_STAGE(PG8_SB(1, 1), b3 + hstep, voffB); PG8_STAGE_A(PG8_SA(1, 0), k3, 0, last); \
            PG8_WAIT_V(8); PG8_WAIT_L(0); PG8_BAR; if (LIVE1) { PG8_MMA2(1, At); } PG8_BAR; PG8_SCHED; \
        } } while (0)
        if (cur.vr > HALF) PG8_KLOOP(true); else PG8_KLOOP(false);
        if constexpr (Epi::ALIGN) { if (wr == 0) PG8_BAR; }
        E(acc, cur, wr, wc, fr, fq, b1, bxw);
        if (!has_next) break;
#pragma unroll
        for (int a = 0; a < 2; ++a)
#pragma unroll
            for (int b = 0; b < 2; ++b)
#pragma unroll
                for (int m = 0; m < 4; ++m)
#pragma unroll
                    for (int n = 0; n < 2; ++n) acc[a][b][m][n] = (f32x4){0.f, 0.f, 0.f, 0.f};
        cur = nxt; cA = nA; cB = nB; ++ui;
        b1 = E.pre(cur, wc, lane);
        if constexpr (Sched::GATHER) { PG8_GIDX(vg, cur); }
        if constexpr (Epi::ALIGN) { if (wr == 1) PG8_BAR; }
    }
    if constexpr (!Epi::ALIGN) { if (wr == 0) PG8_BAR; }
    PG8_WAIT_V(0);
    PG8_BAR;
#undef PG8_SA
#undef PG8_SB
#undef PG8_STAGE
#undef PG8_STAGE_R
#undef PG8_STAGE_A
#undef PG8_KLOOP
#undef PG8_GIDX
#undef PG8_LDA
#undef PG8_LDB
#undef PG8_MMA1
#undef PG8_MMA2
#undef PG8_WAIT_V
#undef PG8_WAIT_L
#undef PG8_BAR
#undef PG8_SCHED
}

constexpr float DA_QSCALE = 0.125f * 1.4426950408889634f;
struct EpiProj {
    static constexpr bool PERM = true, ALIGN = true;
    __device__ __forceinline__ float pre(const Unit&, int, int) const { return 0.f; }
    bf16 *sbq, *sbk, *sbv, *daq, *dak, *dav; const float* rope;
    __device__ __forceinline__ void operator()(const f32x4 (&acc)[2][2][4][2], const Unit& u, int wr, int wc, int fr, int fq, float b1, LAS float* bx) const {
        const int ty = u.pn >> 2;
        bf16* base = ty == 0 ? sbq : ty == 1 ? sbk : ty == 2 ? sbv : ty == 3 ? daq : ty == 4 ? dak : dav;
        const bool kv = (ty != 0 && ty != 3);
        const int bb = u.pm >> 4;
        const int rowadd = kv ? 64 * (bb + 1) : 0;
        const int row0 = u.pm * BM + wr * 64 + fr, col0 = (u.pn & 3) * BM + wc * 32 + 8 * fq;
        const bool rope_wave = (ty == 3 || ty == 4) && ((wc & 1) == 0);
        f32x4 rp4[8][4];
#define ROPE_LD(st) do { if (rope_wave) { const int r_ = row0 + ((st) >> 2) * HALF + ((st) & 3) * 16; const float* rp = rope + (size_t)(NMETA + (r_ & (SEQ - 1))) * 16; \
            rp4[st][0] = *(const f32x4*)(rp); rp4[st][1] = *(const f32x4*)(rp + 4); rp4[st][2] = *(const f32x4*)(rp + 8); rp4[st][3] = *(const f32x4*)(rp + 12); } } while (0)
        ROPE_LD(0); ROPE_LD(1);
#pragma unroll
        for (int st = 0; st < 8; ++st) { const int ai = st >> 2, m = st & 3;
                const int r = row0 + ai * HALF + m * 16;
                bf16* rowp = base + (size_t)(r + rowadd) * HW + col0;
                if (st + 2 < 8) ROPE_LD(st + 2);
#pragma unroll
                for (int bj = 0; bj < 2; ++bj) {
                    f32x4 v0 = acc[ai][bj][m][0], v1 = acc[ai][bj][m][1];
                    if (rope_wave) {
                        const f32x4 cs0 = rp4[st][0], cs1 = rp4[st][1], sn0 = rp4[st][2], sn1 = rp4[st][3];
                        f32x4 o0, o1;
#pragma unroll
                        for (int j = 0; j < 4; ++j) { o0[j] = __shfl_xor(v0[j], 16); o1[j] = __shfl_xor(v1[j], 16); }
                        if (fq == 0) { v0 = v0 * cs0 - o0 * sn0; v1 = v1 * cs1 - o1 * sn1; }
                        else if (fq == 1) { v0 = v0 * cs0 + o0 * sn0; v1 = v1 * cs1 + o1 * sn1; }
                    }
                    if (ty == 3) { v0 = v0 * DA_QSCALE; v1 = v1 * DA_QSCALE; }
                    v4u w; w.x = cvt_pk_bf16(v0[0], v0[1]); w.y = cvt_pk_bf16(v0[2], v0[3]); w.z = cvt_pk_bf16(v1[0], v1[1]); w.w = cvt_pk_bf16(v1[2], v1[3]);
                    *(v4u*)(rowp + bj * HALF) = w; } }
#undef ROPE_LD
    }
};
struct EpiRes {
    static constexpr bool PERM = true, ALIGN = true;
    __device__ __forceinline__ float pre(const Unit&, int, int) const { return 0.f; }
    const float* x; bf16* out;
    __device__ __forceinline__ void operator()(const f32x4 (&acc)[2][2][4][2], const Unit& u, int wr, int wc, int fr, int fq, float b1, LAS float* bx) const {
        const int row0 = u.pm * BM + wr * 64 + fr, col0 = u.pn * BM + wc * 32 + 8 * fq;
        f32x4 xs[8][4];
#define RES_LD(st) do { const size_t off_ = (size_t)(row0 + ((st) >> 2) * HALF + ((st) & 3) * 16) * DM + col0; \
            xs[st][0] = *(const f32x4*)(x + off_); xs[st][1] = *(const f32x4*)(x + off_ + 4); xs[st][2] = *(const f32x4*)(x + off_ + HALF); xs[st][3] = *(const f32x4*)(x + off_ + HALF + 4); } while (0)
        RES_LD(0); RES_LD(1); RES_LD(2); RES_LD(3);
#pragma unroll
        for (int st = 0; st < 8; ++st) { const int ai = st >> 2, m = st & 3; const size_t off = (size_t)(row0 + ai * HALF + m * 16) * DM + col0;
            if (st + 4 < 8) RES_LD(st + 4);
#pragma unroll
            for (int bj = 0; bj < 2; ++bj) { const f32x4 v0 = xs[st][2 * bj] + acc[ai][bj][m][0], v1 = xs[st][2 * bj + 1] + acc[ai][bj][m][1];
                v4u w; w.x = cvt_pk_bf16(v0[0], v0[1]); w.y = cvt_pk_bf16(v0[2], v0[3]); w.z = cvt_pk_bf16(v1[0], v1[1]); w.w = cvt_pk_bf16(v1[2], v1[3]);
                *(v4u*)(out + off + bj * HALF) = w; } }
#undef RES_LD
    }
};
struct EpiSwiglu {
    static constexpr bool PERM = true, ALIGN = false;
    __device__ __forceinline__ float pre(const Unit& u, int wc, int lane) const { return bgu[(size_t)u.e * 4096 + u.pn * HALF + wc * 32 + (lane & 31) + (lane >> 5) * 2048]; }
    bf16* act; const float* bgu;
    __device__ __forceinline__ void operator()(const f32x4 (&acc)[2][2][4][2], const Unit& u, int wr, int wc, int fr, int fq, float b1, LAS float* bx) const {
        const int row0 = u.pm * BM + wr * 64 + fr, col0 = u.pn * HALF + wc * 32 + 8 * fq;
        bx[threadIdx.x & 63] = b1;
        const f32x4 g0 = *(const LAS f32x4*)(bx + 8 * fq), g1 = *(const LAS f32x4*)(bx + 8 * fq + 4), u0 = *(const LAS f32x4*)(bx + 32 + 8 * fq), u1 = *(const LAS f32x4*)(bx + 36 + 8 * fq);
#pragma unroll
        for (int ai = 0; ai < 2; ++ai)
#pragma unroll
            for (int m = 0; m < 4; ++m) {
                bf16* rowp = act + (size_t)(row0 + ai * HALF + m * 16) * DM + col0;
                float o[8];
#pragma unroll
                for (int n = 0; n < 2; ++n)
#pragma unroll
                    for (int j = 0; j < 4; j += 2) {
                        const f32x4 gb = n ? g1 : g0, ub = n ? u1 : u0;
                        const f32x2_t hg = f32x2_t{acc[ai][0][m][n][j], acc[ai][0][m][n][j + 1]} + f32x2_t{gb[j], gb[j + 1]};
                        const f32x2_t hu = f32x2_t{acc[ai][1][m][n][j], acc[ai][1][m][n][j + 1]} + f32x2_t{ub[j], ub[j + 1]};
                        const f32x2_t gt = {fminf(hg[0], 7.0f), fminf(hg[1], 7.0f)}, up = {fminf(fmaxf(hu[0], -7.0f), 7.0f), fminf(fmaxf(hu[1], -7.0f), 7.0f)};
                        const f32x2_t t = gt * (-1.702f * 1.4426950408889634f);
                        const f32x2_t dn = f32x2_t{__builtin_amdgcn_exp2f(t[0]), __builtin_amdgcn_exp2f(t[1])} + 1.0f;
                        const f32x2_t sg = {__builtin_amdgcn_rcpf(dn[0]), __builtin_amdgcn_rcpf(dn[1])};
                        const f32x2_t r2 = (up * gt + gt) * sg;
                        o[n * 4 + j] = r2[0]; o[n * 4 + j + 1] = r2[1]; }
                v4u w; w.x = cvt_pk_bf16(o[0], o[1]); w.y = cvt_pk_bf16(o[2], o[3]); w.z = cvt_pk_bf16(o[4], o[5]); w.w = cvt_pk_bf16(o[6], o[7]);
                *(v4u*)rowp = w; }
    }
};
struct EpiDown {
    static constexpr bool PERM = true, ALIGN = true;
    __device__ __forceinline__ float pre(const Unit& u, int wc, int lane) const { return bdn[(size_t)u.e * DM + u.pn * BM + wc * 32 + (lane & 31) + (lane >> 5) * HALF]; }
    bf16* ys; const float* bdn;
    __device__ __forceinline__ void operator()(const f32x4 (&acc)[2][2][4][2], const Unit& u, int wr, int wc, int fr, int fq, float b1, LAS float* bx) const {
        const int row0 = u.pm * BM + wr * 64 + fr, col0 = u.pn * BM + wc * 32 + 8 * fq;
        bx[threadIdx.x & 63] = b1;
        f32x4 bv[2][2];
#pragma unroll
        for (int bj = 0; bj < 2; ++bj)
#pragma unroll
            for (int n = 0; n < 2; ++n) bv[bj][n] = *(const LAS f32x4*)(bx + bj * 32 + 8 * fq + 4 * n);
#pragma unroll
        for (int ai = 0; ai < 2; ++ai)
#pragma unroll
            for (int m = 0; m < 4; ++m) { bf16* rowp = ys + (size_t)(row0 + ai * HALF + m * 16) * DM + col0;
#pragma unroll
                for (int bj = 0; bj < 2; ++bj) { const f32x4 v0 = acc[ai][bj][m][0] + bv[bj][0], v1 = acc[ai][bj][m][1] + bv[bj][1];
                    v4u w; w.x = cvt_pk_bf16(v0[0], v0[1]); w.y = cvt_pk_bf16(v0[2], v0[3]); w.z = cvt_pk_bf16(v1[0], v1[1]); w.w = cvt_pk_bf16(v1[2], v1[3]);
                    *(v4u*)(rowp + bj * HALF) = w; } }
    }
};
}

struct Args { const float* in[19]; float* out; unsigned char* ws; int ph_lo, ph_hi; };
enum { I_X = 0, I_META, I_GMIX, I_WIN, I_LQ1, I_LK1, I_LQ2, I_LK2, I_GSB, I_GDA, I_WOUT, I_GFFN, I_WR, I_BR, I_WGU, I_BGU, I_WDN, I_BDN, I_GFIN };
constexpr int NWAVES = 8;

struct TrItem { const float* src; bf16* dst; int N; };
__device__ __forceinline__ TrItem tr_decode(const Args& a, int it) {
    unsigned char* ws = a.ws;
    constexpr int T_IN = 32 * (INCOLS / 64), T_OUT = 32 * (DM / 64), T_GU1 = 32 * (4096 / 64), T_DN1 = 32 * (DM / 64);
    TrItem t; int r = it;
    if (r < T_IN) { const int kb = r & 31, nb = r >> 5; t.N = INCOLS; t.src = a.in[I_WIN] + (size_t)(64 * kb) * INCOLS + 64 * nb; t.dst = (bf16*)(ws + WS_WIN) + (size_t)(64 * nb) * DM + 64 * kb; return t; } r -= T_IN;
    if (r < T_OUT) { const int kb = r & 31, nb = r >> 5; t.N = DM; t.src = a.in[I_WOUT] + (size_t)(64 * kb) * DM + 64 * nb; t.dst = (bf16*)(ws + WS_WOUT) + (size_t)(64 * nb) * DM + 64 * kb; return t; } r -= T_OUT;
    if (r < NEXP * T_GU1) { const int e = r / T_GU1, q = r % T_GU1, kb = q & 31, nb = q >> 5, n0 = 64 * nb;
        const int drow0 = n0 < 2048 ? (n0 >> 7) * 256 + (n0 & 127) : ((n0 - 2048) >> 7) * 256 + 128 + ((n0 - 2048) & 127);
        t.N = 4096; t.src = a.in[I_WGU] + (size_t)e * DM * 4096 + (size_t)(64 * kb) * 4096 + n0; t.dst = (bf16*)(ws + WS_WGU) + (size_t)e * 4096 * DM + (size_t)drow0 * DM + 64 * kb; return t; } r -= NEXP * T_GU1;
    { const int e = r / T_DN1, q = r % T_DN1, kb = q & 31, nb = q >> 5;
        t.N = DM; t.src = a.in[I_WDN] + (size_t)e * DM * DM + (size_t)(64 * kb) * DM + 64 * nb; t.dst = (bf16*)(ws + WS_WDN) + (size_t)e * DM * DM + (size_t)(64 * nb) * DM + 64 * kb; return t; }
}
constexpr int TR_NITEMS = 32 * (INCOLS / 64) + 32 * (DM / 64) + NEXP * 32 * (4096 / 64) + NEXP * 32 * (DM / 64);
__device__ __forceinline__ void tr_load(const TrItem& t, f32x4 (&ra)[8], f32x4 (&rb)[8], int lane) {
    const int q = lane >> 4, n4 = lane & 15;
    const float* p = t.src + (size_t)(2 * q) * t.N + 4 * n4;
#pragma unroll
    for (int i = 0; i < 8; ++i) { ra[i] = __builtin_nontemporal_load((const f32x4*)(p + (size_t)(8 * i) * t.N)); rb[i] = __builtin_nontemporal_load((const f32x4*)(p + (size_t)(8 * i + 1) * t.N)); }
}
__device__ __forceinline__ void tr_store(const TrItem& t, const f32x4 (&ra)[8], const f32x4 (&rb)[8], LAS unsigned* scr, int lane) {
    const int q = lane >> 4, n4 = lane & 15;
#pragma unroll
    for (int i = 0; i < 8; ++i)
#pragma unroll
        for (int j = 0; j < 4; ++j) scr[(4 * n4 + j) * 32 + ((i ^ (n4 & 7)) << 2) + q] = cvt2bf(ra[i][j], rb[i][j]);
    LDS_WAIT(); asm volatile("" ::: "memory");
    const int nr = lane >> 3, ch = lane & 7;
#pragma unroll
    for (int i = 0; i < 8; ++i) { const int n = nr + 8 * i; const v4u v = *(const LAS v4u*)(scr + n * 32 + ((ch ^ ((n >> 2) & 7)) << 2));
        __builtin_nontemporal_store(v, (v4u*)(t.dst + (size_t)n * DM + 8 * ch)); }
    LDS_WAIT(); asm volatile("" ::: "memory");
}
constexpr int TR_SMALL = 32 * (INCOLS / 64) + 32 * (DM / 64);
__device__ __forceinline__ void conv_items(const Args& a, LAS unsigned char* lds, int it0, int it1, int vcu, int G, int lane, int wave) {
    LAS unsigned* scr = (LAS unsigned*)(lds + wave * 16384);
    const int gw = vcu * NWAVES + wave, NGW = G * NWAVES;
    f32x4 ra[8], rb[8], na[8], nb_[8];
    int it = it0 + gw;
    if (it >= it1) return;
    TrItem cur = tr_decode(a, it);
    tr_load(cur, ra, rb, lane);
    for (;;) {
        int nx = it + NGW; bool has = nx < it1;
        TrItem nxt = tr_decode(a, has ? nx : it);
        if (has) tr_load(nxt, na, nb_, lane);
        tr_store(cur, ra, rb, scr, lane);
        if (!has) break;
        it = nx; nx = it + NGW; has = nx < it1;
        cur = tr_decode(a, has ? nx : it);
        if (has) tr_load(cur, ra, rb, lane);
        tr_store(nxt, na, nb_, scr, lane);
        if (!has) break;
        it = nx;
    }
}
constexpr int TR_GU_END = TR_SMALL + NEXP * 32 * (4096 / 64);
constexpr int TR_S1 = TR_SMALL + (TR_GU_END - TR_SMALL) * 45 / 100, TR_S2 = TR_SMALL + (TR_GU_END - TR_SMALL) * 85 / 100;
__device__ __forceinline__ void conv_slice(const Args& a, LAS unsigned char* lds, int which, int vcu, int G, int lane, int wave) {
    const int it0 = which == 0 ? TR_SMALL : which == 1 ? TR_S1 : which == 2 ? TR_S2 : TR_GU_END, it1 = which == 0 ? TR_S1 : which == 1 ? TR_S2 : which == 2 ? TR_GU_END : TR_NITEMS;
    conv_items(a, lds, it0, it1, vcu, G, lane, wave);
    __syncthreads();
}
__device__ __forceinline__ void rms_row_to_bf16(const float* xrow, const float* g, bf16* orow, int lane) {
    const f32x4* xr = (const f32x4*)xrow + lane; const f32x4* gr = (const f32x4*)g + lane;
    f32x4 v[8]; float s = 0.f;
#pragma unroll
    for (int j = 0; j < 8; ++j) { v[j] = xr[64 * j]; s += (v[j].x * v[j].x + v[j].y * v[j].y) + (v[j].z * v[j].z + v[j].w * v[j].w); }
    const float rstd = 1.0f / sqrtf(wave_sum(s) * (1.f / DM) + RMS_EPS);
    v2u* o8 = (v2u*)orow + lane;
#pragma unroll
    for (int j = 0; j < 8; ++j) { const f32x4 gg = gr[64 * j]; v2u w; w.x = pk2(v[j].x * rstd * gg.x, v[j].y * rstd * gg.y); w.y = pk2(v[j].z * rstd * gg.z, v[j].w * rstd * gg.w); o8[64 * j] = w; }
}
__device__ __forceinline__ void sincos_rev(double t, float& s, float& c) {
    t -= __builtin_rint(t);
    const double x = t * 6.283185307179586476925286766559, x2 = x * x;
    double ts = x, ss = x, tc = 1.0, cc = 1.0;
#pragma unroll
    for (int k = 1; k <= 14; ++k) { ts *= -x2 / (double)((2 * k) * (2 * k + 1)); ss += ts; tc *= -x2 / (double)((2 * k - 1) * (2 * k)); cc += tc; }
    s = (float)ss; c = (float)cc;
}

__device__ __forceinline__ float rope_inv_freq(int j) {
    return j == 0 ? 1.0f : j == 1 ? 0.1939227432012558f : j == 2 ? 0.03760603070259094f : j == 3 ? 0.007292664609849453f : j == 4 ? 0.0014142135623842478f : j == 5 ? 0.00027424818836152554f : j == 6 ? 5.318296098266728e-05f : 1.0313386155758053e-05f;
}
__device__ __forceinline__ void phase0(const Args& a, LAS unsigned char* lds, int vcu, int G, int tid, int lane, int wave) {
    unsigned char* ws = a.ws;
    for (int unit = vcu; unit < 256; unit += G) {
        LAS float* um = (LAS float*)lds;
        for (int rr = 0; rr < 2; ++rr) { const int r = wave * 2 + rr;
            const f32x4* xr = (const f32x4*)(a.in[I_META] + (size_t)r * DM) + lane; const f32x4* gr = (const f32x4*)a.in[I_GMIX] + lane;
            f32x4 v[8]; float s = 0.f;
#pragma unroll
            for (int j = 0; j < 8; ++j) { v[j] = xr[64 * j]; s += (v[j].x * v[j].x + v[j].y * v[j].y) + (v[j].z * v[j].z + v[j].w * v[j].w); }
            const float rstd = 1.0f / sqrtf(wave_sum(s) * (1.f / DM) + RMS_EPS);
#pragma unroll
            for (int j = 0; j < 8; ++j) { const f32x4 gg = gr[64 * j]; *(LAS f32x4*)(um + r * DM + 4 * (lane + 64 * j)) = v[j] * rstd * gg; } }
        __syncthreads();
        const int grp = unit >> 6, cbase = (unit & 63) * 16;
        const int cl = tid & 15, ks = tid >> 4;
        const int scol = (grp == 0 ? 1024 : grp == 1 ? 2048 : grp == 2 ? 4096 : 5120) + cbase + cl;
        float acc[16];
#pragma unroll
        for (int r = 0; r < 16; ++r) acc[r] = 0.f;
        const float* wp = a.in[I_WIN] + (size_t)(ks * 64) * INCOLS + scol;
#pragma unroll 1
        for (int kb = 0; kb < 8; ++kb) { float w[8];
#pragma unroll
            for (int q = 0; q < 8; ++q) w[q] = wp[(size_t)(kb * 8 + q) * INCOLS];
#pragma unroll
            for (int q4 = 0; q4 < 2; ++q4)
#pragma unroll
                for (int r = 0; r < 16; ++r) { const f32x4 u = *(const LAS f32x4*)(um + r * DM + ks * 64 + kb * 8 + 4 * q4);
                    acc[r] += (u.x * w[4 * q4] + u.y * w[4 * q4 + 1]) + (u.z * w[4 * q4 + 2] + u.w * w[4 * q4 + 3]); } }
        __syncthreads();
        LAS float* red = (LAS float*)lds;
#pragma unroll
        for (int r = 0; r < 16; ++r) red[(ks * 16 + r) * 16 + cl] = acc[r];
        __syncthreads();
        LAS float* res = red + 32 * 16 * 16;
        if (tid < 256) { float sm = 0.f;
#pragma unroll
            for (int q = 0; q < 32; ++q) sm += red[(q * 16 + (tid >> 4)) * 16 + (tid & 15)];
            res[tid] = sm; }
        __syncthreads();
        bf16* dst = (bf16*)(ws + (grp == 0 ? WS_SBK : grp == 1 ? WS_SBV : grp == 2 ? WS_DAK : WS_DAV));
        if (tid < 256) { const int r = tid >> 4, c = tid & 15; float v = res[tid];
            if (grp == 2) { const int d = (cbase + c) & 63;
                if (d < 16) { float sn, cs; { const float ang = (float)r * rope_inv_freq(d & 7); sincos_rev((double)ang * 0.15915494309189533576888376337251, sn, cs); }
                    const float other = res[r * 16 + (c ^ 8)];
                    v = (d < 8) ? v * cs - other * sn : v * cs + other * sn; } }
            const unsigned short bv = (unsigned short)f2bf(v);
#pragma unroll
            for (int b = 0; b < BATCH; ++b) dst[(size_t)(b * LPB + KVPAD + r) * HW + cbase + c] = bv; }
        __syncthreads();
    }
    { const int gt = vcu * 512 + tid, NT = G * 512;
      for (int i = gt; i < 4 * BATCH * KVPAD * (HW / 8); i += NT) { const int t = i / (BATCH * KVPAD * (HW / 8)), rem = i % (BATCH * KVPAD * (HW / 8)), b = rem / (KVPAD * (HW / 8)), rr = (rem / (HW / 8)) % KVPAD, c8 = rem % (HW / 8);
          bf16* dst = (bf16*)(ws + (t == 0 ? WS_SBK : t == 1 ? WS_SBV : t == 2 ? WS_DAK : WS_DAV));
          *(v4u*)(dst + (size_t)(b * LPB + rr) * HW + c8 * 8) = (v4u){0u, 0u, 0u, 0u}; }
      float* rope = (float*)(ws + WS_ROPE);
      for (int i = gt; i < (NMETA + SEQ) * 8; i += NT) { const int pos = i >> 3, j = i & 7;
          const float ang = (float)pos * rope_inv_freq(j); float sn, cs; sincos_rev((double)ang * 0.15915494309189533576888376337251, sn, cs);
          rope[pos * 16 + j] = cs; rope[pos * 16 + 8 + j] = sn; }
      { float* wgt = (float*)(ws + WS_WG); for (int i = gt; i < DM * NEXP; i += NT) wgt[i] = a.in[I_GFFN][i >> 5] * a.in[I_WR][i]; }
      if (vcu == 0 && wave == 0) { const float d1 = wave_sum(a.in[I_LQ1][lane] * a.in[I_LK1][lane]), d2 = wave_sum(a.in[I_LQ2][lane] * a.in[I_LK2][lane]);
          if (lane == 0) ((float*)(ws + WS_CTL))[CW_LAM] = expf(d1) - expf(d2) + LAM_INIT; } }
    conv_items(a, lds, 0, TR_SMALL, vcu, G, lane, wave);
    { const int gw = vcu * NWAVES + wave, NGW = G * NWAVES;
      f32x4 gg[8], cur[8];
      { const f32x4* gr = (const f32x4*)a.in[I_GMIX] + lane;
#pragma unroll
        for (int j = 0; j < 8; ++j) gg[j] = gr[64 * j]; }
      { const f32x4* xr = (const f32x4*)(a.in[I_X] + (size_t)(gw < NTOK ? gw : NTOK - 1) * DM) + lane;
#pragma unroll
        for (int j = 0; j < 8; ++j) cur[j] = xr[64 * j]; }
      for (int m = gw; m < NTOK; m += NGW) {
          f32x4 nxt[8];
          { const int mn = m + NGW < NTOK ? m + NGW : NTOK - 1; const f32x4* xr = (const f32x4*)(a.in[I_X] + (size_t)mn * DM) + lane;
#pragma unroll
            for (int j = 0; j < 8; ++j) nxt[j] = xr[64 * j]; }
          float sq = 0.f;
#pragma unroll
          for (int j = 0; j < 8; ++j) sq += (cur[j].x * cur[j].x + cur[j].y * cur[j].y) + (cur[j].z * cur[j].z + cur[j].w * cur[j].w);
          const float rstd = __builtin_amdgcn_rsqf(wave_sum(sq) * (1.f / DM) + RMS_EPS);
          v2u* o8 = (v2u*)((bf16*)(ws + WS_U) + (size_t)m * DM) + lane;
#pragma unroll
          for (int j = 0; j < 8; ++j) { const f32x4 uu = cur[j] * rstd * gg[j]; v2u w; w.x = cvt2bf(uu.x, uu.y); w.y = cvt2bf(uu.z, uu.w); o8[64 * j] = w; }
#pragma unroll
          for (int j = 0; j < 8; ++j) cur[j] = nxt[j];
      }
    }
}

__device__ __forceinline__ void phase4(const Args& a, LAS unsigned char* lds, int vcu, int G, int tid, int lane, int wave) {
    unsigned char* ws = a.ws;
    LAS float* xs = (LAS float*)lds;
    LAS float* red = (LAS float*)(lds + 66048);
    LAS float* lg = (LAS float*)(lds + 99840);
    LAS float* rsd = (LAS float*)(lds + 104064);
    LAS unsigned* cl = (LAS unsigned*)(lds + 104192);
    LAS int* sel_e = (LAS int*)(lds + 104448); LAS int* sel_r = sel_e + 128; LAS float* sel_g = (LAS float*)(sel_r + 128);
    int* r_e = (int*)(ws + WS_ROUTE); float* r_g = (float*)(ws + WS_ROUTE + 256 * 1024); int* r_rank = (int*)(ws + WS_ROUTE + 512 * 1024);
    int* elist = (int*)(ws + WS_ELIST);
    unsigned* cnt = (unsigned*)(ws + WS_CTL) + CW_CNT;
    const float* wg = (const float*)(ws + WS_WG);
    const int r32 = lane & 31, hi = lane >> 5;
    f32x4 gff[8];
    { const f32x4* gr = (const f32x4*)a.in[I_GFFN] + lane;
#pragma unroll
      for (int j = 0; j < 8; ++j) gff[j] = gr[64 * j]; }
    for (int grp = vcu; grp < NTOK / 32; grp += G) {
        const int tok0 = grp * 32;
        f32x4 v[4][8]; float rs4[4];
#pragma unroll
        for (int rr = 0; rr < 4; ++rr) { const int m = tok0 + 4 * wave + rr;
            const v2u* xr = (const v2u*)((const bf16*)(ws + WS_U) + (size_t)m * DM) + lane;
            float s = 0.f;
#pragma unroll
            for (int j = 0; j < 8; ++j) { const v2u hw = xr[64 * j]; v[rr][j] = (f32x4){bflo(hw.x), bfhi(hw.x), bflo(hw.y), bfhi(hw.y)}; s += (v[rr][j].x * v[rr][j].x + v[rr][j].y * v[rr][j].y) + (v[rr][j].z * v[rr][j].z + v[rr][j].w * v[rr][j].w); }
            rs4[rr] = 1.0f / sqrtf(wave_sum(s) * (1.f / DM) + RMS_EPS); }
#pragma unroll
        for (int rr = 0; rr < 4; ++rr) { const int m = tok0 + 4 * wave + rr; const float rstd = rs4[rr];
            v2u* o8 = (v2u*)((bf16*)(ws + WS_U2) + (size_t)m * DM) + lane;
#pragma unroll
            for (int j = 0; j < 8; ++j) { const f32x4 uu = v[rr][j] * rstd * gff[j]; v2u w; w.x = cvt2bf(uu.x, uu.y); w.y = cvt2bf(uu.z, uu.w); o8[64 * j] = w; }
            if (lane == 0) rsd[4 * wave + rr] = rstd; }
        if (tid < 32) cl[tid] = 0u;
        f32x16 acc;
#pragma unroll
        for (int r = 0; r < 16; ++r) acc[r] = 0.f;
#pragma unroll
        for (int sl = 0; sl < 4; ++sl) {
#pragma unroll
            for (int rr = 0; rr < 4; ++rr)
#pragma unroll
                for (int jj = 0; jj < 2; ++jj) *(LAS f32x4*)(xs + (4 * wave + rr) * 516 + 4 * lane + 256 * jj) = v[rr][2 * sl + jj];
            __syncthreads();
            const float* wp = wg + (size_t)(512 * sl + 64 * wave + hi) * NEXP + r32;
            const LAS float* xp = xs + r32 * 516 + 64 * wave + hi;
#pragma unroll 8
            for (int st = 0; st < 32; ++st) acc = __builtin_amdgcn_mfma_f32_32x32x2f32(wp[st * 2 * NEXP], xp[2 * st], acc, 0, 0, 0);
            __syncthreads();
        }
#pragma unroll
        for (int r = 0; r < 16; ++r) red[(wave * 32 + r32) * 33 + ((r & 3) + 8 * (r >> 2) + 4 * hi)] = acc[r];
        __syncthreads();
        { const int tk = tid >> 4, e0 = (tid & 15) * 2;
#pragma unroll
          for (int q = 0; q < 2; ++q) { float sm = 0.f;
#pragma unroll
              for (int w8 = 0; w8 < 8; ++w8) sm += red[(w8 * 32 + tk) * 33 + e0 + q];
              lg[tk * 33 + e0 + q] = sm * rsd[tk] + a.in[I_BR][e0 + q]; } }
        __syncthreads();
        if (tid < 32) {
            unsigned taken = 0u; float sv[4]; int si[4];
#pragma unroll
            for (int r = 0; r < 4; ++r) { float bv = -3.0e38f; int bi = 0;
                for (int e = 0; e < NEXP; ++e) { const float x = lg[tid * 33 + e]; if (!((taken >> e) & 1u) && x > bv) { bv = x; bi = e; } }
                sv[r] = bv; si[r] = bi; taken |= 1u << bi; }
            const float e1 = __expf(sv[1] - sv[0]), e2 = __expf(sv[2] - sv[0]), e3 = __expf(sv[3] - sv[0]), inv = 1.0f / (1.0f + e1 + e2 + e3);
#pragma unroll
            for (int r = 0; r < 4; ++r) { sel_e[tid * 4 + r] = si[r]; sel_g[tid * 4 + r] = (r == 0 ? 1.0f : r == 1 ? e1 : r == 2 ? e2 : e3) * inv;
                sel_r[tid * 4 + r] = (int)__hip_atomic_fetch_add(cl + si[r], 1u, __ATOMIC_RELAXED, __HIP_MEMORY_SCOPE_WORKGROUP); }
        }
        __syncthreads();
        if (tid < 32) { const unsigned c = cl[tid]; cl[32 + tid] = c ? __hip_atomic_fetch_add(cnt + 64 * tid, c, __ATOMIC_RELAXED, __HIP_MEMORY_SCOPE_AGENT) : 0u; }
        __syncthreads();
        if (tid < 128) { const int e = sel_e[tid], rank = (int)cl[32 + e] + sel_r[tid], tok = tok0 + (tid >> 2);
            r_e[tok * 4 + (tid & 3)] = e; r_g[tok * 4 + (tid & 3)] = sel_g[tid]; r_rank[tok * 4 + (tid & 3)] = rank; elist[(size_t)e * NTOK + rank] = tok; }
        __syncthreads();
    }
}
__device__ __forceinline__ int moe_build_tiles(const Args& a, LAS unsigned char* lds, int tid) {
    unsigned* ctl = (unsigned*)(a.ws + WS_CTL);
    LAS int* tp = (LAS int*)(lds + MISC_OFF + 1024); LAS int* te = (LAS int*)(lds + TE_OFF); LAS unsigned* cn = (LAS unsigned*)(lds + CNT_OFF);
    if (tid < NEXP) cn[tid] = __hip_atomic_load(ctl + CW_CNT + 64 * tid, __ATOMIC_RELAXED, __HIP_MEMORY_SCOPE_AGENT);
    __syncthreads();
    if (tid == 0) { int s = 0; for (int e = 0; e < NEXP; ++e) { tp[e] = s; s += (int)((cn[e] + 255u) >> 8); } tp[NEXP] = s; }
    __syncthreads();
    for (int e = 0; e < NEXP; ++e) { const int lo = tp[e], hi = tp[e + 1]; for (int t = lo + tid; t < hi; t += 512) te[t] = e; }
    __syncthreads();
    return tp[NEXP];
}
__device__ __forceinline__ void phase7(const Args& a, LAS unsigned char* lds, int vcu, int G, int tid, int lane, int wave) {
    unsigned char* ws = a.ws;
    unsigned* ctl = (unsigned*)(ws + WS_CTL);
    LAS int* tp = (LAS int*)(lds + MISC_OFF + 1024);
    { LAS unsigned* cn = (LAS unsigned*)(lds + CNT_OFF);
      if (tid < NEXP) cn[tid] = __hip_atomic_load(ctl + CW_CNT + 64 * tid, __ATOMIC_RELAXED, __HIP_MEMORY_SCOPE_AGENT);
      __syncthreads();
      if (tid == 0) { int s = 0; for (int e = 0; e < NEXP; ++e) { tp[e] = s; s += (int)((cn[e] + 255u) >> 8); } tp[NEXP] = s; } }
    __syncthreads();
    const int gw = vcu * NWAVES + wave, NGW = G * NWAVES;
    const int* r_e = (const int*)(ws + WS_ROUTE); const float* r_g = (const float*)(ws + WS_ROUTE + 256 * 1024); const int* r_rank = (const int*)(ws + WS_ROUTE + 512 * 1024);
    f32x4 gfin[8];
    { const f32x4* gr = (const f32x4*)a.in[I_GFIN] + 2 * lane;
#pragma unroll
      for (int j = 0; j < 4; ++j) { gfin[2 * j] = gr[128 * j]; gfin[2 * j + 1] = gr[128 * j + 1]; } }
    int e_c[4], rk_c[4]; float g_c[4]; v4u h_c[4];
    { const int t0 = gw < NTOK ? gw : NTOK - 1; const v4u* hr = (const v4u*)((const bf16*)(ws + WS_U) + (size_t)t0 * DM) + lane;
#pragma unroll
      for (int r = 0; r < 4; ++r) { e_c[r] = r_e[t0 * 4 + r]; rk_c[r] = r_rank[t0 * 4 + r]; g_c[r] = r_g[t0 * 4 + r]; }
#pragma unroll
      for (int j = 0; j < 4; ++j) h_c[j] = hr[64 * j]; }
    for (int tok = gw; tok < NTOK; tok += NGW) {
        v4u y[4][4];
#pragma unroll
        for (int r = 0; r < 4; ++r) { const size_t pos = (size_t)tp[e_c[r]] * 256 + rk_c[r]; const v4u* yr = (const v4u*)((const bf16*)(ws + WS_YS) + pos * DM) + lane;
#pragma unroll
            for (int j = 0; j < 4; ++j) y[r][j] = yr[64 * j]; }
        int e_n[4], rk_n[4]; float g_n[4]; v4u h_n[4];
        { const int tn = tok + NGW < NTOK ? tok + NGW : NTOK - 1; const v4u* hr = (const v4u*)((const bf16*)(ws + WS_U) + (size_t)tn * DM) + lane;
#pragma unroll
          for (int r = 0; r < 4; ++r) { e_n[r] = r_e[tn * 4 + r]; rk_n[r] = r_rank[tn * 4 + r]; g_n[r] = r_g[tn * 4 + r]; }
#pragma unroll
          for (int j = 0; j < 4; ++j) h_n[j] = hr[64 * j]; }
        float v[4][8];
#pragma unroll
        for (int j = 0; j < 4; ++j) { const v4u hw = h_c[j];
            v[j][0] = bflo(hw.x); v[j][1] = bfhi(hw.x); v[j][2] = bflo(hw.y); v[j][3] = bfhi(hw.y); v[j][4] = bflo(hw.z); v[j][5] = bfhi(hw.z); v[j][6] = bflo(hw.w); v[j][7] = bfhi(hw.w); }
#pragma unroll
        for (int r = 0; r < 4; ++r) { const float gte = g_c[r];
#pragma unroll
            for (int j = 0; j < 4; ++j) { const v4u w = y[r][j];
                v[j][0] += gte * bflo(w.x); v[j][1] += gte * bfhi(w.x); v[j][2] += gte * bflo(w.y); v[j][3] += gte * bfhi(w.y);
                v[j][4] += gte * bflo(w.z); v[j][5] += gte * bfhi(w.z); v[j][6] += gte * bflo(w.w); v[j][7] += gte * bfhi(w.w); } }
#pragma unroll
        for (int r = 0; r < 4; ++r) { e_c[r] = e_n[r]; rk_c[r] = rk_n[r]; g_c[r] = g_n[r]; h_c[r] = h_n[r]; }
        float s = 0.f;
#pragma unroll
        for (int j = 0; j < 4; ++j)
#pragma unroll
            for (int q = 0; q < 8; ++q) s += v[j][q] * v[j][q];
        const float rstd = 1.0f / sqrtf(wave_sum(s) * (1.f / DM) + RMS_EPS);
        f32x4* xr = (f32x4*)(a.out + (size_t)tok * DM) + 2 * lane;
#pragma unroll
        for (int j = 0; j < 4; ++j) { const f32x4 g0 = gfin[2 * j], g1 = gfin[2 * j + 1];
            xr[128 * j] = (f32x4){v[j][0] * rstd * g0.x, v[j][1] * rstd * g0.y, v[j][2] * rstd * g0.z, v[j][3] * rstd * g0.w};
            xr[128 * j + 1] = (f32x4){v[j][4] * rstd * g1.x, v[j][5] * rstd * g1.y, v[j][6] * rstd * g1.z, v[j][7] * rstd * g1.w}; }
    }
}
namespace att {
using s16x4 = __attribute__((ext_vector_type(4))) short;
#define KSWZ(row, colB) ((row) * 256 + ((colB) ^ (((row) & 7) << 4)))
#define SBAR() __builtin_amdgcn_sched_barrier(0)
__device__ __forceinline__ int crow(int r, int hi) { return (r & 3) + 8 * (r >> 2) + 4 * hi; }
__device__ __forceinline__ unsigned cvtpk(float lo, float hi) { return cvt2bf(lo, hi); }
__device__ __forceinline__ int v_st(int k, int c) { const int kk = (k & ~0xC) | ((k & 4) << 1) | ((k & 8) >> 1); return ((kk >> 3) * 4 + (c >> 5)) * 512 + ((kk & 7) * 32 + (c & 31)) * 2; }
__device__ __forceinline__ int v_rd_base(int lane) { return ((lane & 3) << 3) | (((lane >> 2) & 3) << 6) | (((lane >> 4) & 1) << 5) | (((lane >> 5) & 1) << 8); }
constexpr int v_rd_off(int d0, int ks, int half) { return d0 * 512 + ks * 4096 + half * 2048; }
template <int OFF> __device__ __forceinline__ s16x4 tr_read(int vb) { s16x4 r; asm volatile("ds_read_b64_tr_b16 %0, %1 offset:%2" : "=&v"(r) : "v"(vb), "i"(OFF) : "memory"); return r; }
#define ATT_RDK(X, KS) do { X##0 = tr_read<v_rd_off(0, KS, 0)>(vb); X##1 = tr_read<v_rd_off(0, KS, 1)>(vb); X##2 = tr_read<v_rd_off(1, KS, 0)>(vb); X##3 = tr_read<v_rd_off(1, KS, 1)>(vb); \
    X##4 = tr_read<v_rd_off(2, KS, 0)>(vb); X##5 = tr_read<v_rd_off(2, KS, 1)>(vb); X##6 = tr_read<v_rd_off(3, KS, 0)>(vb); X##7 = tr_read<v_rd_off(3, KS, 1)>(vb); } while (0)
#define ATT_PKV(L, H) (bf16x8){L[0], L[1], L[2], L[3], H[0], H[1], H[2], H[3]}
#define ATT_MMAK(PA, X) do { o[0] = __builtin_amdgcn_mfma_f32_32x32x16_bf16(PA, ATT_PKV(X##0, X##1), o[0], 0, 0, 0); o[1] = __builtin_amdgcn_mfma_f32_32x32x16_bf16(PA, ATT_PKV(X##2, X##3), o[1], 0, 0, 0); \
    o[2] = __builtin_amdgcn_mfma_f32_32x32x16_bf16(PA, ATT_PKV(X##4, X##5), o[2], 0, 0, 0); o[3] = __builtin_amdgcn_mfma_f32_32x32x16_bf16(PA, ATT_PKV(X##6, X##7), o[3], 0, 0, 0); } while (0)
__device__ __forceinline__ void pv_pipe(f32x16* o, int vb, bf16x8 pa0, bf16x8 pa1, bf16x8 pa2, bf16x8 pa3) {
    s16x4 a0, a1, a2, a3, a4, a5, a6, a7, b0, b1, b2, b3, b4, b5, b6, b7;
    SBAR(); ATT_RDK(a, 0); ATT_RDK(b, 1);
    asm volatile("s_waitcnt lgkmcnt(8)" ::: "memory"); SBAR(); ATT_MMAK(pa0, a);
    SBAR(); ATT_RDK(a, 2);
    asm volatile("s_waitcnt lgkmcnt(8)" ::: "memory"); SBAR(); ATT_MMAK(pa1, b);
    SBAR(); ATT_RDK(b, 3);
    asm volatile("s_waitcnt lgkmcnt(8)" ::: "memory"); SBAR(); ATT_MMAK(pa2, a);
    asm volatile("s_waitcnt lgkmcnt(0)" ::: "memory"); SBAR(); ATT_MMAK(pa3, b);
}
template <int BLK> __device__ __forceinline__ void pv_half(f32x16* o, int vb, bf16x8 paA, bf16x8 paB) {
    s16x4 a0, a1, a2, a3, a4, a5, a6, a7, b0, b1, b2, b3, b4, b5, b6, b7;
    SBAR(); ATT_RDK(a, 2 * BLK); ATT_RDK(b, 2 * BLK + 1);
    asm volatile("s_waitcnt lgkmcnt(8)" ::: "memory"); SBAR(); ATT_MMAK(paA, a);
    asm volatile("s_waitcnt lgkmcnt(0)" ::: "memory"); SBAR(); ATT_MMAK(paB, b);
}
#define ATT_PK4(P, BASE, OUT) do { unsigned a0_ = cvtpk(P[BASE + 0], P[BASE + 1]), a1_ = cvtpk(P[BASE + 2], P[BASE + 3]);   \
    unsigned b0_ = cvtpk(P[BASE + 4], P[BASE + 5]), b1_ = cvtpk(P[BASE + 6], P[BASE + 7]);                              \
    auto r0_ = __builtin_amdgcn_permlane32_swap(a0_, b0_, false, false); auto r1_ = __builtin_amdgcn_permlane32_swap(a1_, b1_, false, false); \
    v4u w_ = {r0_[0], r1_[0], r0_[1], r1_[1]}; OUT = *reinterpret_cast<bf16x8*>(&w_); } while (0)

constexpr int SHM_T = 16384;
struct AttDma { unsigned ko[2], vo[2]; };
__device__ __forceinline__ AttDma att_dma_init(int wave, int lane) {
    AttDma d;
#pragma unroll
    for (int i = 0; i < 2; ++i) { const int c = wave + 8 * i;
        { const int row = 4 * c + (lane >> 4), ch = (lane & 15) ^ (row & 7); d.ko[i] = (unsigned)(row * HW + ch * 8) * 2u; }
        { const int st = 2 * c + (lane >> 5), kk = (st >> 2) * 8 + ((lane & 31) >> 2), col = (st & 3) * 32 + 8 * (lane & 3);
          const int k = (kk & ~0xC) | ((kk & 4) << 1) | ((kk & 8) >> 1); d.vo[i] = (unsigned)(k * HW + col) * 2u; } }
    return d;
}
__device__ __forceinline__ void att_dma(const AttDma& d, const bf16* __restrict__ Kh, const bf16* __restrict__ Vh, int key0, LAS unsigned char* Kdst, LAS unsigned char* Vdst, int wave) {
    const __amdgpu_buffer_rsrc_t rk = __builtin_amdgcn_make_buffer_rsrc((void*)Kh, 0, 0x7fffffff, 0x00020000), rv = __builtin_amdgcn_make_buffer_rsrc((void*)Vh, 0, 0x7fffffff, 0x00020000);
    const int so = key0 * HW * 2;
#pragma unroll
    for (int i = 0; i < 2; ++i) { const int c = wave + 8 * i;
        __builtin_amdgcn_raw_ptr_buffer_load_lds(rk, (LAS void*)(Kdst + c * 1024), 16, (int)d.ko[i], so, 0, 0);
        __builtin_amdgcn_raw_ptr_buffer_load_lds(rv, (LAS void*)(Vdst + c * 1024), 16, (int)d.vo[i], so, 0, 0); }
}
__device__ __forceinline__ float half_sum32(float v) {
    v += __builtin_bit_cast(float, __builtin_amdgcn_update_dpp(0, __builtin_bit_cast(int, v), 0xB1, 0xf, 0xf, false));
    v += __builtin_bit_cast(float, __builtin_amdgcn_update_dpp(0, __builtin_bit_cast(int, v), 0x4E, 0xf, 0xf, false));
    v += __builtin_bit_cast(float, __builtin_amdgcn_update_dpp(0, __builtin_bit_cast(int, v), 0x141, 0xf, 0xf, false));
    v += __builtin_bit_cast(float, __builtin_amdgcn_update_dpp(0, __builtin_bit_cast(int, v), 0x140, 0xf, 0xf, false));
    return v + __shfl_xor(v, 16);
}
__device__ __forceinline__ void park2(LAS unsigned char* stg, int r, int hi, int r32, int d, float y0, float y1) {
    const unsigned w = cvt2bf(y0, y1); LAS unsigned char* rp = stg + crow(r, hi) * 256 + 2 * r32;
    *(LAS bf16*)(rp + 64 * (d ^ hi)) = (bf16)(w & 0xffffu); *(LAS bf16*)(rp + 64 * ((d + 1) ^ hi)) = (bf16)(w >> 16);
}
__device__ __forceinline__ void store_rows(const LAS unsigned char* stg, bf16* __restrict__ dst  , int lane) {
#pragma unroll
    for (int i = 0; i < 8; ++i) { const int row = (lane >> 4) + 4 * i, pc = lane & 15;
        const v4u w = *(const LAS v4u*)(stg + row * 256 + ((pc * 16) ^ ((i & 1) << 6)));
        *(v4u*)(dst + (size_t)row * DM + pc * 8) = w; }
}
__device__ __forceinline__ void da_unit(LAS unsigned char* lds, const bf16* __restrict__ Q, const bf16* __restrict__ Kp, const bf16* __restrict__ Vp, const float* __restrict__ gda, float lam,
                                        bf16* __restrict__ mixed, int b, int h, int qt, int tid, int wave, int lane) {
    constexpr float THR2 = 8.0f * 1.4426950408889634f;
    const int r32 = lane & 31, hi = lane >> 5, rg = wave & 3, comp = wave >> 2;
    LAS unsigned char* V_lds = lds; LAS unsigned char* K_lds = lds + 4 * SHM_T; LAS float* X = (LAS float*)lds;
    LAS float* wsf = (LAS float*)(lds + MISC_OFF + 2048) + wave * 64; LAS float* li_l = wsf; LAS float* al_l = wsf + 32;
    const int m0 = b * SEQ + 128 * qt;
    bf16x8 qr[4];
    { const bf16* Qw = Q + (size_t)(m0 + 32 * rg + r32) * HW + h * 128 + comp * 64 + hi * 8;
#pragma unroll
      for (int d0 = 0; d0 < 4; ++d0) qr[d0] = *(const bf16x8*)(Qw + d0 * 16); }
    const bf16* Kh = Kp + (size_t)(b * LPB) * HW + h * 128; const bf16* Vh = Vp + (size_t)(b * LPB) * HW + h * 128;
    const int vb0 = (int)(unsigned)(uintptr_t)V_lds + v_rd_base(lane);
    const int NT = 2 * qt + 3, NTw = 2 * qt + 2 + (rg >> 1);
    const AttDma dm = att_dma_init(wave, lane);
    att_dma(dm, Kh, Vh, 0, K_lds, V_lds, wave);
    att_dma(dm, Kh, Vh, 64, K_lds + SHM_T, V_lds + SHM_T, wave);
    int kbuf = 0;
    float m_reg = 0.f, l_reg = 0.f; f32x16 o[4];
    f32x16 mneg;
#pragma unroll
    for (int r = 0; r < 16; ++r) mneg[r] = 0.f;
#pragma unroll
    for (int d = 0; d < 4; ++d)
#pragma unroll
        for (int r = 0; r < 16; ++r) o[d][r] = 0.f;
    bf16x8 pa0, pa1, pa2, pa3; bool pend = false; int pbuf = 0, vbuf = 0;
#pragma unroll
    for (int q = 0; q < 8; ++q) { pa0[q] = 0; pa1[q] = 0; pa2[q] = 0; pa3[q] = 0; }
    for (int j = 0; j < NT; ++j) {
        const int buf = kbuf;
        if (j + 1 < NT) asm volatile("s_waitcnt vmcnt(4)" ::: "memory"); else asm volatile("s_waitcnt vmcnt(0)" ::: "memory");
        __syncthreads();
        if (j + 2 < NT) att_dma(dm, Kh, Vh, (j + 2) * 64, K_lds + (kbuf == 0 ? 2 : kbuf - 1) * SHM_T, V_lds + ((vbuf + 2) & 3) * SHM_T, wave);
        if (comp == 1 && pend) { pv_pipe(o, vb0 + pbuf * SHM_T, pa0, pa1, pa2, pa3); pend = false; }
        if (j < NTw) {
            f32x16 p0 = mneg, p1 = mneg;
            { const LAS unsigned char* Ks = K_lds + buf * SHM_T; bf16x8 kb0[4], kb1[4];
#pragma unroll
              for (int d0 = 0; d0 < 4; ++d0) { const int cb = (comp * 64 + d0 * 16 + hi * 8) * 2;
                  kb0[d0] = *(const LAS bf16x8*)(Ks + KSWZ(r32, cb)); kb1[d0] = *(const LAS bf16x8*)(Ks + KSWZ(32 + r32, cb)); }
              SBAR();
#pragma unroll
              for (int d0 = 0; d0 < 4; ++d0) { p0 = __builtin_amdgcn_mfma_f32_32x32x16_bf16(kb0[d0], qr[d0], p0, 0, 0, 0); p1 = __builtin_amdgcn_mfma_f32_32x32x16_bf16(kb1[d0], qr[d0], p1, 0, 0, 0); } }
            if (j == 0) {
#pragma unroll
                for (int r = 0; r < 16; ++r) p0[r] = -INFINITY;
#pragma unroll
                for (int r = 0; r < 8; ++r) p1[r] = -INFINITY;
            }
            float pmax = p0[0];
#pragma unroll
            for (int r = 1; r < 16; ++r) pmax = fmaxf(pmax, p0[r]);
#pragma unroll
            for (int r = 0; r < 16; ++r) pmax = fmaxf(pmax, p1[r]);
            { auto rr = __builtin_amdgcn_permlane32_swap(__builtin_bit_cast(unsigned, pmax), __builtin_bit_cast(unsigned, pmax), false, false);
              pmax = fmaxf(__builtin_bit_cast(float, rr[0]), __builtin_bit_cast(float, rr[1])); }
            float alpha = 1.f;
            if (j == 0 || !__all(pmax <= THR2)) {
                const float dl = j == 0 ? pmax : fmaxf(pmax, 0.f);
                alpha = j == 0 ? 1.f : __builtin_amdgcn_exp2f(-dl); m_reg += dl;
#pragma unroll
                for (int r = 0; r < 16; ++r) { p0[r] -= dl; p1[r] -= dl; mneg[r] = -m_reg; }
            }
#pragma unroll
            for (int r = 0; r < 16; ++r) { p0[r] = __builtin_amdgcn_exp2f(p0[r]); p1[r] = __builtin_amdgcn_exp2f(p1[r]); }
            if (__any(alpha < 1.f)) { if (hi == 0) al_l[r32] = alpha; asm volatile("s_waitcnt lgkmcnt(0)" ::: "memory");
#pragma unroll
                for (int r = 0; r < 16; ++r) { const float al = al_l[crow(r, hi)];
#pragma unroll
                    for (int d = 0; d < 4; ++d) o[d][r] *= al; } }
            float ps = 0.f;
#pragma unroll
            for (int r = 0; r < 16; ++r) ps += p0[r];
#pragma unroll
            for (int r = 0; r < 16; ++r) ps += p1[r];
            { auto rr = __builtin_amdgcn_permlane32_swap(__builtin_bit_cast(unsigned, ps), __builtin_bit_cast(unsigned, ps), false, false);
              ps = __builtin_bit_cast(float, rr[0]) + __builtin_bit_cast(float, rr[1]); }
            l_reg = l_reg * alpha + ps;
            ATT_PK4(p0, 0, pa0); ATT_PK4(p0, 8, pa1); ATT_PK4(p1, 0, pa2); ATT_PK4(p1, 8, pa3);
            if (comp == 0) pv_pipe(o, vb0 + vbuf * SHM_T, pa0, pa1, pa2, pa3); else { pend = true; pbuf = vbuf; }
        }
        vbuf = (vbuf + 1) & 3; kbuf = kbuf == 2 ? 0 : kbuf + 1;
    }
    if (pend) pv_pipe(o, vb0 + pbuf * SHM_T, pa0, pa1, pa2, pa3);
    if (hi == 0) li_l[r32] = l_reg;
    asm volatile("s_waitcnt lgkmcnt(0)" ::: "memory");
    float rli[16];
#pragma unroll
    for (int r = 0; r < 16; ++r) rli[r] = __builtin_amdgcn_rcpf(li_l[crow(r, hi)]);
    __syncthreads();
    if (comp == 1) {
#pragma unroll
        for (int r = 0; r < 16; ++r) { const float f = rli[r] * lam;
#pragma unroll
            for (int d = 0; d < 4; ++d) X[(rg * 32 + crow(r, hi)) * 128 + 32 * d + r32] = o[d][r] * f; }
    }
    __syncthreads();
    if (comp == 0) {
        float gg[4];
#pragma unroll
        for (int d = 0; d < 4; ++d) gg[d] = gda[h * 128 + 32 * d + r32] * (1.0f - LAM_INIT);
        LAS unsigned char* stg = lds + 4 * SHM_T + rg * 8192;
#pragma unroll
        for (int r = 0; r < 16; ++r) { float ss = 0.f; float v[4];
#pragma unroll
            for (int d = 0; d < 4; ++d) { v[d] = o[d][r] * rli[r] - X[(rg * 32 + crow(r, hi)) * 128 + 32 * d + r32]; ss += v[d] * v[d]; }
            ss = half_sum32(ss);
            const float rs = __builtin_amdgcn_rsqf(ss * (1.f / 128.f) + RMS_EPS);
            park2(stg, r, hi, r32, 0, v[0] * rs * gg[0], v[1] * rs * gg[1]); park2(stg, r, hi, r32, 2, v[2] * rs * gg[2], v[3] * rs * gg[3]); }
        store_rows(stg, mixed + (size_t)(m0 + 32 * rg) * DM + 1024 + h * 128, lane);
    }
    __syncthreads();
}

constexpr float SB_THR2 = -155.0f;
template <bool MASK> __device__ __forceinline__ void sb_block(f32x16& p, float& running, int kofs, int lo, int lim, int hi) {
    constexpr float C1 = 0.08838834764831845f * 1.4426950408889634f;
    float L[16];
#pragma unroll
    for (int r = 0; r < 16; ++r) { const float z2 = p[r] * C1, t = __builtin_amdgcn_exp2f(-fabsf(z2)); const float sp = fmaxf(z2, 0.f) + __builtin_amdgcn_logf(1.0f + t);
        const int kk = kofs + crow(r, hi); const bool valid = !MASK || (kk >= lo && kk < lim);
        L[r] = valid ? -sp : 0.f; p[r] = valid ? z2 : -1.0e30f; }
    float G[4], PG[4];
#pragma unroll
    for (int g = 0; g < 4; ++g) { G[g] = (L[4 * g] + L[4 * g + 1]) + (L[4 * g + 2] + L[4 * g + 3]); PG[g] = __shfl_xor(G[g], 32); }
#pragma unroll
    for (int g = 3; g >= 0; --g) { const float off = running + (hi == 0 ? PG[g] : 0.f);
        const float c3 = L[4 * g + 3] + off, c2 = L[4 * g + 2] + c3, c1 = L[4 * g + 1] + c2, c0 = L[4 * g] + c1;
        p[4 * g + 3] = __builtin_amdgcn_exp2f(p[4 * g + 3] + c3); p[4 * g + 2] = __builtin_amdgcn_exp2f(p[4 * g + 2] + c2);
        p[4 * g + 1] = __builtin_amdgcn_exp2f(p[4 * g + 1] + c1); p[4 * g] = __builtin_amdgcn_exp2f(p[4 * g] + c0);
        running += G[g] + PG[g]; }
}
__device__ __forceinline__ void sb_unit(LAS unsigned char* lds, const bf16* __restrict__ Q, const bf16* __restrict__ Kp, const bf16* __restrict__ Vp, const float* __restrict__ gsb,
                                        bf16* __restrict__ mixed, int b, int h, int qt, int tid, int wave, int lane) {
    const int r32 = lane & 31, hi = lane >> 5;
    LAS unsigned char* V_lds = lds; LAS unsigned char* K_lds = lds + 2 * SHM_T;
    LAS unsigned* fl = (LAS unsigned*)(lds + MISC_OFF + 4096);
    const int m0 = b * SEQ + 256 * qt;
    LAS unsigned char* Qs = lds + 4 * SHM_T + wave * 8192;
    { const bf16* Qw = Q + (size_t)(m0 + 32 * wave + r32) * HW + h * 128 + hi * 8;
#pragma unroll
      for (int d0 = 0; d0 < 8; ++d0) { const bf16x8 qv = *(const bf16x8*)(Qw + d0 * 16); *(LAS bf16x8*)(Qs + KSWZ(r32, (d0 * 16 + hi * 8) * 2)) = qv; } }
    const bf16* Kh = Kp + (size_t)(b * LPB) * HW + h * 128; const bf16* Vh = Vp + (size_t)(b * LPB) * HW + h * 128;
    const int vb0 = (int)(unsigned)(uintptr_t)V_lds + v_rd_base(lane);
    int kb[4];
#pragma unroll
    for (int bq = 0; bq < 4; ++bq) kb[bq] = r32 * 256 + ((bq * 32 + hi * 16) ^ ((r32 & 7) << 4));
    const int jtop = 4 * qt + 4, jw = 4 * qt + 1 + (wave >> 1);
    const int Prow = 64 + 256 * qt + 32 * wave + r32;
    if (lane == 0) { fl[wave] = 0u; fl[8 + wave] = 0u; }
    { const AttDma dm = att_dma_init(wave, lane); att_dma(dm, Kh, Vh, jtop * 64, K_lds, V_lds, wave); }
    float carry = 0.f; bool done = false; f32x16 o[4];
#pragma unroll
    for (int d = 0; d < 4; ++d)
#pragma unroll
        for (int r = 0; r < 16; ++r) o[d][r] = 0.f;
    for (int j = jtop, it = 0; j >= 0; --j, ++it) {
        const int buf = it & 1;
        asm volatile("s_waitcnt vmcnt(0)" ::: "memory");
        __syncthreads();
        if (it > 0) { const v4u f0 = *(const LAS v4u*)(fl + ((it - 1) & 1) * 8), f1 = *(const LAS v4u*)(fl + ((it - 1) & 1) * 8 + 4);
            if ((f0.x & f0.y & f0.z & f0.w & f1.x & f1.y & f1.z & f1.w) != 0u) break; }
        if (j > 0) { int z = 0; asm volatile("" : "+v"(z));
            const AttDma dm = att_dma_init(wave, lane + z); att_dma(dm, Kh, Vh, (j - 1) * 64, K_lds + (buf ^ 1) * SHM_T, V_lds + (buf ^ 1) * SHM_T, wave); }
        if (!done && j <= jw) {
            const bool need_mask = (j == jw) || (j == 0);
            const int lim = Prow - 64 * j, lo = (j == 0) ? KVPAD : 0;
            float running = carry;
            const LAS unsigned char* Ks = K_lds + buf * SHM_T;
            {   f32x16 p;
#pragma unroll
                for (int r = 0; r < 16; ++r) p[r] = 0.f;
#pragma unroll
                for (int d0 = 0; d0 < 8; ++d0) { const int ko = kb[d0 & 3] + (d0 >> 2) * 128;
                    const bf16x8 b1 = *(const LAS bf16x8*)(Ks + ko + 8192), qv = *(const LAS bf16x8*)(Qs + ko); p = __builtin_amdgcn_mfma_f32_32x32x16_bf16(b1, qv, p, 0, 0, 0); }
                if (need_mask) sb_block<true>(p, running, 32, lo, lim, hi); else sb_block<false>(p, running, 32, lo, lim, hi);
                bf16x8 paA, paB; ATT_PK4(p, 0, paA); ATT_PK4(p, 8, paB);
                pv_half<1>(o, vb0 + buf * SHM_T, paA, paB); }
            SBAR();
            {   f32x16 p;
#pragma unroll
                for (int r = 0; r < 16; ++r) p[r] = 0.f;
#pragma unroll
                for (int d0 = 0; d0 < 8; ++d0) { const int ko = kb[d0 & 3] + (d0 >> 2) * 128;
                    const bf16x8 b0 = *(const LAS bf16x8*)(Ks + ko), qv = *(const LAS bf16x8*)(Qs + ko); p = __builtin_amdgcn_mfma_f32_32x32x16_bf16(b0, qv, p, 0, 0, 0); }
                if (need_mask) sb_block<true>(p, running, 0, lo, lim, hi); else sb_block<false>(p, running, 0, lo, lim, hi);
                bf16x8 paA, paB; ATT_PK4(p, 0, paA); ATT_PK4(p, 8, paB);
                pv_half<0>(o, vb0 + buf * SHM_T, paA, paB); }
            carry = running;
            done = __all(carry < SB_THR2);
        }
        if (lane == 0) fl[(it & 1) * 8 + wave] = done ? 1u : 0u;
    }
    { float gg[4];
#pragma unroll
      for (int d = 0; d < 4; ++d) gg[d] = gsb[h * 128 + 32 * d + r32];
#pragma unroll
      for (int r = 0; r < 16; ++r) { float ss = 0.f;
#pragma unroll
          for (int d = 0; d < 4; ++d) ss += o[d][r] * o[d][r];
          ss = half_sum32(ss);
          const float rs = __builtin_amdgcn_rsqf(ss * (1.f / 128.f) + RMS_EPS);
          park2(Qs, r, hi, r32, 0, o[0][r] * rs * gg[0], o[1][r] * rs * gg[1]); park2(Qs, r, hi, r32, 2, o[2][r] * rs * gg[2], o[3][r] * rs * gg[3]); }
      store_rows(Qs, mixed + (size_t)(m0 + 32 * wave) * DM + h * 128, lane); }
    __syncthreads();
}
}

__device__ __forceinline__ void phase_attn(const Args& a, LAS unsigned char* lds, int vcu, int G, int tid, int lane, int wave) {
    unsigned char* ws = a.ws;
    const float lam = ((const float*)(ws + WS_CTL))[CW_LAM];
    for (int idx = vcu; idx < 256; idx += G) {
        const int s16 = idx & 15;
        for (int k = 0; k < 4; ++k) { const int bh = ((idx >> 5) << 2) + 2 * (k >> 1) + ((idx >> 4) & 1), b = bh >> 3, h = bh & 7, qt = (k & 1) ? 31 - s16 : s16;
            att::da_unit(lds, (const bf16*)(ws + WS_DAQ), (const bf16*)(ws + WS_DAK), (const bf16*)(ws + WS_DAV), a.in[I_GDA], lam, (bf16*)(ws + WS_MIX), b, h, qt, tid, wave, lane); }
    }
    for (int idx = vcu; idx < 256; idx += G) {
        const int bh = idx >> 3, s = idx & 7, b = bh >> 3, h = bh & 7;
        for (int k = 0; k < 2; ++k)
            att::sb_unit(lds, (const bf16*)(ws + WS_SBQ), (const bf16*)(ws + WS_SBK), (const bf16*)(ws + WS_SBV), a.in[I_GSB], (bf16*)(ws + WS_MIX), b, h, 2 * s + k, tid, wave, lane);
    }
}

enum { PH_PRO = 0, PH_INPROJ, PH_ATTN, PH_OUTPROJ, PH_ROUTE, PH_GATEUP, PH_DOWN, PH_FINAL, PH_N };
__global__ void __launch_bounds__(NWAVES * 64, 2) fwd(Args args) {
    extern __shared__ __attribute__((aligned(16))) unsigned char lds_raw[];
    LAS unsigned char* lds = (LAS unsigned char*)lds_raw;
    const int tid = threadIdx.x, lane = tid & 63, wave = __builtin_amdgcn_readfirstlane(tid >> 6);
    const int G = gridDim.x; const int bx = blockIdx.x; const int vcu = (G % 8 == 0) ? (bx % 8) * (G / 8) + bx / 8 : bx;
    unsigned char* ws = args.ws;
    unsigned* ctl = (unsigned*)(ws + WS_CTL);
    volatile LAS unsigned* MISC = (volatile LAS unsigned*)(lds + MISC_OFF);
    if (tid < 64) MISC[tid] = 0u;
    __syncthreads();
    XcdBarrier bar; bar.bar = ctl + CW_BAR; bar.x = 0; bar.st = MISC + 8;
    const int lo = args.ph_lo, hi = args.ph_hi;
    if (hi - lo > 1) bar = xcd_barrier_post(ctl + CW_BAR, MISC + 8);
#define IN(k) (lo <= (k) && (k) < hi)
#define SEAM(k) do { if (IN(k) && IN((k) + 1)) xcd_barrier(bar); } while (0)

    if (IN(PH_PRO)) { for (int rep = 0; rep < REP_PRO; ++rep) phase0(args, lds, vcu, G, tid, lane, wave); SEAM(PH_PRO); }
    if (IN(PH_INPROJ)) {
        pg8::DenseOrder S; S.init((const bf16*)(ws + WS_U), (const bf16*)(ws + WS_WIN), NTOK, INCOLS, G, bx);
        pg8::EpiProj E{(bf16*)(ws + WS_SBQ), (bf16*)(ws + WS_SBK), (bf16*)(ws + WS_SBV), (bf16*)(ws + WS_DAQ), (bf16*)(ws + WS_DAK), (bf16*)(ws + WS_DAV), (const float*)(ws + WS_ROPE)};
        if ((vcu & 1) == 0) conv_slice(args, lds, 0, vcu, G, lane, wave);
        for (int rep = 0; rep < REP_INPROJ; ++rep) pg8::gemm_phase<pg8::EpiProj, pg8::DenseOrder>(lds, S, E);
        if ((vcu & 1) != 0) conv_slice(args, lds, 0, vcu, G, lane, wave);
        SEAM(PH_INPROJ);
    }
    if (IN(PH_ATTN)) { if ((vcu & 1) == 0) conv_slice(args, lds, 1, vcu, G, lane, wave);
        for (int rep = 0; rep < REP_ATTN; ++rep) phase_attn(args, lds, vcu, G, tid, lane, wave);
        __syncthreads(); if ((vcu & 1) != 0) conv_slice(args, lds, 1, vcu, G, lane, wave); SEAM(PH_ATTN); }
    if (IN(PH_OUTPROJ)) {
        pg8::DenseOrder S; S.init((const bf16*)(ws + WS_MIX), (const bf16*)(ws + WS_WOUT), NTOK, DM, G, bx);
        pg8::EpiRes E{args.in[I_X], (bf16*)(ws + WS_U)};
        if ((vcu & 1) == 0) conv_slice(args, lds, 2, vcu, G, lane, wave);
        pg8::gemm_phase<pg8::EpiRes, pg8::DenseOrder>(lds, S, E);
        if ((vcu & 1) != 0) conv_slice(args, lds, 2, vcu, G, lane, wave);
        SEAM(PH_OUTPROJ);
    }
    if (IN(PH_ROUTE)) { phase4(args, lds, vcu, G, tid, lane, wave); SEAM(PH_ROUTE); }
    if (IN(PH_GATEUP)) {
        const int ntiles = __builtin_amdgcn_readfirstlane(moe_build_tiles(args, lds, tid));
        pg8::MoeOrder<true> S; S.init((const bf16*)(ws + WS_U2), (const bf16*)(ws + WS_WGU), ntiles, 4096, lds, ctl + CW_QUEUE + 64 * (bx & 7), bx & 7);
        {
            const LAS int* tp = (const LAS int*)(lds + MISC_OFF + 1024); const LAS unsigned* cn = (const LAS unsigned*)(lds + CNT_OFF); const LAS int* te = (const LAS int*)(lds + TE_OFF);
            LAS unsigned short* gidx = (LAS unsigned short*)(lds + IDX_OFF); const int* elist = (const int*)(ws + WS_ELIST);
            const int total = (ntiles - S.mlo < IDX_TILES ? ntiles - S.mlo : IDX_TILES) * 256;
#pragma unroll 4
            for (int q = tid; q < total; q += 512) { const int T = S.mlo + (q >> 8), e = te[T], rank = (T - tp[e]) * 256 + (q & 255); gidx[q] = (unsigned short)elist[(size_t)e * NTOK + (rank < (int)cn[e] ? rank : 0)]; }
        }
        S.prefetch(0); S.prefetch(1); __syncthreads();
        pg8::EpiSwiglu E{(bf16*)(ws + WS_ACT), args.in[I_BGU]};
        {
            const int cut = 2 * (vcu & 7);
#pragma unroll 1
            for (int part = 0; part < 2; ++part) {
                if (part == 1) { int z = 0; asm volatile("" : "+s"(z));
                    conv_slice(args, lds, 3, vcu + z, G, lane + z, wave + z); }
                S.base = part ? (S.ndone < cut ? S.ndone : cut) : 0; S.cap = part ? (1 << 30) : cut;
                S.ndone = 0;
                if (S.cap > 0) pg8::gemm_phase<pg8::EpiSwiglu, pg8::MoeOrder<true>>(lds, S, E);
            }
        }
        SEAM(PH_GATEUP);
    }
    if (IN(PH_DOWN)) {
        const int ntiles = __builtin_amdgcn_readfirstlane(moe_build_tiles(args, lds, tid));
        pg8::MoeOrder<false> S; S.init((const bf16*)(ws + WS_ACT), (const bf16*)(ws + WS_WDN), ntiles, DM, lds, ctl + CW_QUEUE + 64 * (8 + (bx & 7)), bx & 7);
        S.prefetch(0); S.prefetch(1); __syncthreads();
        pg8::EpiDown E{(bf16*)(ws + WS_YS), args.in[I_BDN]};
        for (int rep = 0; rep < REP_DOWN; ++rep) pg8::gemm_phase<pg8::EpiDown, pg8::MoeOrder<false>>(lds, S, E);
        SEAM(PH_DOWN);
    }
    if (IN(PH_FINAL)) { phase7(args, lds, vcu, G, tid, lane, wave); }
#undef IN
#undef SEAM
}

extern "C" void kernel_launch(void* const* d_in, const int* in_sizes, int n_in, void* d_out, int out_size, void* d_ws, size_t ws_size, hipStream_t stream) {
    static int grid = 0;
    if (grid == 0) {
        if (n_in != 19 || out_size != NTOK * DM || ws_size < WS_END) { fprintf(stderr, "kernel_launch: unexpected shapes (n_in %d out %d ws %zu)\n", n_in, out_size, ws_size); grid = -1; return; }
        int dev = 0, cus = 0, per_cu = 0;
        if (hipGetDevice(&dev) != hipSuccess || hipDeviceGetAttribute(&cus, hipDeviceAttributeMultiprocessorCount, dev) != hipSuccess) { grid = -1; return; }
        if (hipFuncSetAttribute((const void*)fwd, hipFuncAttributeMaxDynamicSharedMemorySize, LDS_BYTES) != hipSuccess) { fprintf(stderr, "kernel_launch: hipFuncSetAttribute failed\n"); grid = -1; return; }
        if (hipOccupancyMaxActiveBlocksPerMultiprocessor(&per_cu, (const void*)fwd, NWAVES * 64, LDS_BYTES) != hipSuccess || per_cu < 1) { fprintf(stderr, "kernel_launch: occupancy query says %d\n", per_cu); }
        (void)hipGetLastError();
        grid = cus;
    }
    if (grid < 0) return;
    (void)in_sizes;
    (void)hipMemsetAsync((char*)d_ws + WS_CTL, 0, CTL_ZERO_BYTES, stream);
    Args a{};
    for (int i = 0; i < 19; ++i) a.in[i] = (const float*)d_in[i];
    a.out = (float*)d_out; a.ws = (unsigned char*)d_ws;
#if N_LAUNCH_MODE == 1
    a.ph_lo = 0; a.ph_hi = PH_N;
    hipLaunchKernelGGL(fwd, dim3(grid), dim3(NWAVES * 64), LDS_BYTES, stream, a);
#else
    for (int ph = 0; ph < PH_N; ++ph) {
        a.ph_lo = ph; a.ph_hi = ph + 1;
        hipLaunchKernelGGL(fwd, dim3(grid), dim3(NWAVES * 64), LDS_BYTES, stream, a);
    }
#endif
    const hipError_t le = hipPeekAtLastError();
    if (le != hipSuccess) fprintf(stderr, "kernel_launch: launch failed: %s\n", hipGetErrorName(le));
}
```
